# Optimizing an MI355X kernel written in HIP

```python
import jax, jax.numpy as jnp
from jax import lax
import numpy as np

D_MODEL = 2048
BATCH = 1
SEQ = 16384
DEPTH = 2

HEAD_DIM = 128
ATTN_WIDTH = D_MODEL // 2
N_ATTN_HEADS = ATTN_WIDTH // HEAD_DIM
CONV_CH = D_MODEL // 4
CONV_GROUPS = CONV_CH // HEAD_DIM
CONV_K = 3
MEM_WIDTH = D_MODEL // 4
N_MEM_HEADS = MEM_WIDTH // HEAD_DIM
MEM_TOKENS = 256
MIX_WIDTH = ATTN_WIDTH + CONV_CH + MEM_WIDTH
IN_WIDTH = 3 * ATTN_WIDTH + 3 * CONV_CH + MEM_WIDTH
IN_SPLITS = [ATTN_WIDTH, 2 * ATTN_WIDTH, 3 * ATTN_WIDTH,
             3 * ATTN_WIDTH + CONV_CH, 3 * ATTN_WIDTH + 2 * CONV_CH,
             3 * ATTN_WIDTH + 3 * CONV_CH]
D_FF = 11 * D_MODEL // 4
FFN_RES = 0.5
MOBA_BLOCK = 256
MOBA_TOPK = 3
Q_CHUNK = 128
ROPE_THETA = 10000.0
RMS_EPS = 1e-6

kernel_name = "hymba_moba_shortconv_memory_macaron"


def rms_norm(x, g):
    xf = x.astype(jnp.float32)
    y = xf * lax.rsqrt(jnp.mean(xf * xf, axis=-1, keepdims=True) + RMS_EPS)
    return (y * g.astype(jnp.float32)).astype(x.dtype)


def swiglu(h, w_gate_up, w_down):
    g, u = jnp.split(h @ w_gate_up, 2, axis=-1)
    return (jax.nn.silu(g) * u) @ w_down


def rope_tables(positions):
    inv_freq = ROPE_THETA ** (-jnp.arange(0, HEAD_DIM, 2, dtype=jnp.float32) / HEAD_DIM)
    ang = positions.astype(jnp.float32)[..., None] * inv_freq
    return jnp.cos(ang)[:, :, None, :], jnp.sin(ang)[:, :, None, :]


def apply_rope(x, cos, sin):
    xf = x.astype(jnp.float32)
    x1, x2 = jnp.split(xf, 2, axis=-1)
    return jnp.concatenate([x1 * cos - x2 * sin, x2 * cos + x1 * sin], axis=-1).astype(x.dtype)


def moba_attention(q, k, v):
    b, s, h, d = q.shape
    n_blk = -(-s // MOBA_BLOCK)
    s_pad = n_blk * MOBA_BLOCK
    top_k = min(MOBA_TOPK, n_blk)
    scale = d ** -0.5
    qh = q.transpose(0, 2, 1, 3)
    pad = ((0, 0), (0, 0), (0, s_pad - s), (0, 0))
    kh = jnp.pad(k.transpose(0, 2, 1, 3), pad)
    vh = jnp.pad(v.transpose(0, 2, 1, 3), pad)
    k_blocks = kh.reshape(b, h, n_blk, MOBA_BLOCK, d)
    v_blocks = vh.reshape(b, h, n_blk, MOBA_BLOCK, d)
    k_mean = jnp.mean(k_blocks.astype(jnp.float32), axis=3)
    bi = jnp.arange(b)[:, None, None, None]
    hi = jnp.arange(h)[None, :, None, None]
    blk_ids = jnp.arange(n_blk)

    def chunk(ci):
        start = ci * Q_CHUNK
        qblk = start // MOBA_BLOCK
        qc = lax.dynamic_slice_in_dim(qh, start, Q_CHUNK, axis=2)
        gate = jnp.einsum('bhqd,bhnd->bhqn', qc.astype(jnp.float32), k_mean)
        gate = jnp.where(blk_ids < qblk, gate, -jnp.inf)
        _, idx = lax.top_k(gate, top_k)
        valid = idx < qblk
        k_sel = k_blocks[bi, hi, idx]
        v_sel = v_blocks[bi, hi, idx]
        s_sel = jnp.einsum('bhqd,bhqtkd->bhqtk', qc, k_sel,
                           preferred_element_type=jnp.float32) * scale
        s_sel = jnp.where(valid[..., None], s_sel, -jnp.inf)
        blk_start = qblk * MOBA_BLOCK
        k_own = lax.dynamic_slice_in_dim(kh, blk_start, MOBA_BLOCK, axis=2)
        v_own = lax.dynamic_slice_in_dim(vh, blk_start, MOBA_BLOCK, axis=2)
        s_own = jnp.einsum('bhqd,bhkd->bhqk', qc, k_own,
                           preferred_element_type=jnp.float32) * scale
        q_pos = start + jnp.arange(Q_CHUNK)
        k_pos = blk_start + jnp.arange(MOBA_BLOCK)
        s_own = jnp.where(k_pos[None, :] <= q_pos[:, None], s_own, -jnp.inf)
        n_sel = top_k * MOBA_BLOCK
        logits = jnp.concatenate([s_sel.reshape(b, h, Q_CHUNK, n_sel), s_own], axis=-1)
        p = jax.nn.softmax(logits, axis=-1).astype(v.dtype)
        p_sel = p[..., :n_sel].reshape(b, h, Q_CHUNK, top_k, MOBA_BLOCK)
        p_own = p[..., n_sel:]
        return (jnp.einsum('bhqtk,bhqtkd->bhqd', p_sel, v_sel)
                + jnp.einsum('bhqk,bhkd->bhqd', p_own, v_own))

    out = lax.map(chunk, jnp.arange(s // Q_CHUNK))
    return out.transpose(1, 0, 3, 2, 4).reshape(b, s, h * d)


def short_conv(u, w):
    s = u.shape[1]
    up = jnp.pad(u, ((0, 0), (CONV_K - 1, 0), (0, 0)))
    y = up[:, 0:s] * w[0]
    for j in range(1, CONV_K):
        y = y + up[:, j:j + s] * w[j]
    return y


def memory_attention(mq, mkv, q_g, k_g):
    b, s, _ = mq.shape
    m = mkv.shape[1]
    q = rms_norm(mq.reshape(b, s, N_MEM_HEADS, HEAD_DIM), q_g)
    mk, mv = jnp.split(mkv, 2, axis=-1)
    k = rms_norm(mk.reshape(b, m, N_MEM_HEADS, HEAD_DIM), k_g)
    v = mv.reshape(b, m, N_MEM_HEADS, HEAD_DIM)
    sc = jnp.einsum('bshd,bmhd->bhsm', q, k, preferred_element_type=jnp.float32) * HEAD_DIM ** -0.5
    p = jax.nn.softmax(sc, axis=-1).astype(v.dtype)
    return jnp.einsum('bhsm,bmhd->bshd', p, v).reshape(b, s, MEM_WIDTH)


def setup_inputs(seed: int = 0) -> dict:
    key = jax.random.key(seed)
    ks = jax.random.split(key, 20)

    def w(k, shape, fan_in):
        return jax.random.normal(k, shape, jnp.float32) * fan_in ** -0.5

    def gain(k, shape):
        return 1.0 + 0.01 * jax.random.normal(k, shape, jnp.float32)

    return {
        "x": jax.random.normal(ks[0], (BATCH, SEQ, D_MODEL), jnp.float32),
        "mem": jax.random.normal(ks[1], (BATCH, MEM_TOKENS, D_MODEL), jnp.float32),
        "positions": jnp.broadcast_to(jnp.arange(SEQ, dtype=jnp.int32), (BATCH, SEQ)),
        "ffn1_norm": gain(ks[2], (DEPTH, D_MODEL)),
        "ffn1_w_gate_up": w(ks[3], (DEPTH, D_MODEL, 2 * D_FF), D_MODEL),
        "ffn1_w_down": w(ks[4], (DEPTH, D_FF, D_MODEL), D_FF),
        "mix_norm": gain(ks[5], (DEPTH, D_MODEL)),
        "w_in": w(ks[6], (DEPTH, D_MODEL, IN_WIDTH), D_MODEL),
        "q_norm": gain(ks[7], (DEPTH, HEAD_DIM)),
        "k_norm": gain(ks[8], (DEPTH, HEAD_DIM)),
        "conv_w": w(ks[9], (DEPTH, CONV_K, CONV_CH), CONV_K),
        "mem_norm": gain(ks[10], (DEPTH, D_MODEL)),
        "w_mem_kv": w(ks[11], (DEPTH, D_MODEL, 2 * MEM_WIDTH), D_MODEL),
        "mq_norm": gain(ks[12], (DEPTH, HEAD_DIM)),
        "mk_norm": gain(ks[13], (DEPTH, HEAD_DIM)),
        "w_out": w(ks[14], (DEPTH, MIX_WIDTH, D_MODEL), MIX_WIDTH),
        "ffn2_norm": gain(ks[15], (DEPTH, D_MODEL)),
        "ffn2_w_gate_up": w(ks[16], (DEPTH, D_MODEL, 2 * D_FF), D_MODEL),
        "ffn2_w_down": w(ks[17], (DEPTH, D_FF, D_MODEL), D_FF),
    }


def reference(x, mem, positions, ffn1_norm, ffn1_w_gate_up, ffn1_w_down, mix_norm, w_in,
              q_norm, k_norm, conv_w, mem_norm, w_mem_kv, mq_norm, mk_norm, w_out,
              ffn2_norm, ffn2_w_gate_up, ffn2_w_down):
    b, s, _ = x.shape
    cos, sin = rope_tables(positions)
    for i in range(DEPTH):
        x = x + FFN_RES * swiglu(rms_norm(x, ffn1_norm[i]), ffn1_w_gate_up[i], ffn1_w_down[i])
        h = rms_norm(x, mix_norm[i])
        proj = h @ w_in[i]
        q, k, v, c_b, c_c, c_x, m_q = jnp.split(proj, IN_SPLITS, axis=-1)
        q = apply_rope(rms_norm(q.reshape(b, s, N_ATTN_HEADS, HEAD_DIM), q_norm[i]), cos, sin)
        k = apply_rope(rms_norm(k.reshape(b, s, N_ATTN_HEADS, HEAD_DIM), k_norm[i]), cos, sin)
        v = v.reshape(b, s, N_ATTN_HEADS, HEAD_DIM)
        y_attn = moba_attention(q, k, v)
        y_conv = c_b * short_conv(c_c * c_x, conv_w[i])
        mkv = rms_norm(mem, mem_norm[i]) @ w_mem_kv[i]
        y_mem = memory_attention(m_q, mkv, mq_norm[i], mk_norm[i])
        x = x + jnp.concatenate([y_attn, y_conv, y_mem], axis=-1) @ w_out[i]
        x = x + FFN_RES * swiglu(rms_norm(x, ffn2_norm[i]), ffn2_w_gate_up[i], ffn2_w_down[i])
    return x
```

```cpp
#include <hip/hip_runtime.h>
#include <hip/hip_cooperative_groups.h>
#include <cstdio>
#include <cstdint>
#include <cmath>
namespace cg = cooperative_groups;
namespace pg8 {
#define PG8_LAS __attribute__((address_space(3)))
typedef unsigned short bf16_t;
typedef short bf16x8 __attribute__((ext_vector_type(8)));
typedef float f32x4 __attribute__((ext_vector_type(4)));
typedef unsigned u32x4 __attribute__((ext_vector_type(4)));
constexpr int BM = 256, BK = 64, HALF = 128, HTB = HALF * BK * 2  , STAGE_BYTES = 8 * HTB, NXCD = 8, WGM = 8;

__host__ __device__ __forceinline__ int lds_byte(int r, int c) { const int st = (r >> 4) * 2 + (c >> 5), rr = r & 15, cc = c & 31, ob = rr * 64 + cc * 2; return st * 1024 + (ob ^ (((ob >> 9) & 1) << 5)); }
__host__ __device__ __forceinline__ void stage_rc(int b, int& R, int& C) { const int st = b / 1024, sb = b % 1024, swz = sb ^ (((sb >> 9) & 1) << 5); R = (st >> 1) * 16 + swz / 64; C = (st & 1) * 32 + (swz % 64) / 2; }
__host__ __device__ __forceinline__ int perm32(int rho) { const int n = rho >> 4, i = rho & 15; return 8 * (i >> 2) + 4 * n + (i & 3); }

struct Unit { int pm, pn; };
struct Gemm { const bf16_t* A; const bf16_t* Bt; int M, N, K; };

struct StaticOrder {
    int nM, nN, nwg, G, c;
    __host__ __device__ void init(int M, int N, int G_, int c_) { nM = M / BM; nN = N / BM; nwg = nM * nN; G = G_; c = c_; }
    __host__ __device__ bool next(int i, Unit& u) const {
        const long L = (long)i * G + c; if (L >= nwg) return false;
        int wgid = (int)L; { const int q = nwg / NXCD, r = nwg % NXCD, xcd = wgid % NXCD, off = wgid / NXCD; wgid = (xcd < r ? xcd * (q + 1) : r * (q + 1) + (xcd - r) * q) + off; }
        const int nig = WGM * nN, gid = wgid / nig, fm = gid * WGM, gsz = (nM - fm) < WGM ? (nM - fm) : WGM;
        u.pm = fm + ((wgid % nig) % gsz); u.pn = (wgid % nig) / gsz; return true;
    }
    __device__ __forceinline__ void a_ready(const Unit&) const {}
    __device__ __forceinline__ void done(const Unit&) const {}
};

__device__ __forceinline__ unsigned cvt_pk_bf16(float lo, float hi) { unsigned r; asm volatile("v_cvt_pk_bf16_f32 %0, %1, %2" : "=v"(r) : "v"(lo), "v"(hi)); return r; }
typedef float f32x2 __attribute__((ext_vector_type(2)));
struct EpiF32 {
    static constexpr bool PERM = false, AFTER_DRAIN = false;
    float* C; int ldc;
    __device__ __forceinline__ void operator()(const f32x4 (&acc)[2][2][4][2], const Unit& u, int wr, int wc, int fr, int fq) const {
        const int row0 = u.pm * BM + wr * 64 + fr, col0 = u.pn * BM + wc * 32 + 4 * fq;
#pragma unroll
        for (int ai = 0; ai < 2; ++ai)
#pragma unroll
            for (int m = 0; m < 4; ++m) { float* rowp = C + (size_t)(row0 + ai * HALF + m * 16) * ldc + col0;
#pragma unroll
                for (int bj = 0; bj < 2; ++bj)
#pragma unroll
                    for (int n = 0; n < 2; ++n) *(f32x4*)(rowp + bj * HALF + n * 16) = acc[ai][bj][m][n]; }
    }
};
__device__ __forceinline__ float row_rstd(const float* ssq, int row, int fq) {
    const f32x4* p = (const f32x4*)(ssq + (size_t)row * 32 + fq * 8);
    const f32x4 a = p[0], b = p[1];
    float s = ((a[0] + a[1]) + (a[2] + a[3])) + ((b[0] + b[1]) + (b[2] + b[3]));
    s += __shfl_xor(s, 16); s += __shfl_xor(s, 32);
    return 1.0f / sqrtf(s * (1.0f / 2048.0f) + 1e-6f);
}
__device__ __forceinline__ f32x4 swiglu4(f32x4 g, f32x4 u) {
    f32x4 o;
#pragma unroll
    for (int e = 0; e < 4; ++e) { const float t = __builtin_amdgcn_exp2f(g[e] * -1.4426950408889634f); o[e] = g[e] * __builtin_amdgcn_rcpf(1.0f + t) * u[e]; }
    return o;
}
struct EpiSwiglu {
    static constexpr bool PERM = true, AFTER_DRAIN = false;
    bf16_t* H; const float* ssq; mutable float rs[2][4]; mutable int last_pm;
    __device__ __forceinline__ void operator()(const f32x4 (&acc)[2][2][4][2], const Unit& u, int wr, int wc, int fr, int fq) const {
        const int row0 = u.pm * BM + wr * 64 + fr, col0 = u.pn * HALF + wc * 32 + 8 * fq;
        if (u.pm != last_pm) { last_pm = u.pm;
#pragma unroll
            for (int ai = 0; ai < 2; ++ai)
#pragma unroll
                for (int m = 0; m < 4; ++m) rs[ai][m] = row_rstd(ssq, row0 + ai * HALF + m * 16, fq); }
#pragma unroll
        for (int ai = 0; ai < 2; ++ai)
#pragma unroll
            for (int m = 0; m < 4; ++m) { const int row = row0 + ai * HALF + m * 16; const float r = rs[ai][m];
                const f32x4 h0 = swiglu4(acc[ai][0][m][0] * r, acc[ai][1][m][0] * r), h1 = swiglu4(acc[ai][0][m][1] * r, acc[ai][1][m][1] * r);
                u32x4 w; w.x = cvt_pk_bf16(h0[0], h0[1]); w.y = cvt_pk_bf16(h0[2], h0[3]); w.z = cvt_pk_bf16(h1[0], h1[1]); w.w = cvt_pk_bf16(h1[2], h1[3]);
                *(u32x4*)(H + (size_t)row * 5632 + col0) = w; }
    }
};
struct EpiProj {
    static constexpr bool PERM = true, AFTER_DRAIN = false;
    bf16_t* P; int ldc; const float* ssq; mutable float rs[2][4]; mutable int last_pm;
    __device__ __forceinline__ void operator()(const f32x4 (&acc)[2][2][4][2], const Unit& u, int wr, int wc, int fr, int fq) const {
        const int row0 = u.pm * BM + wr * 64 + fr, col0 = u.pn * BM + wc * 32 + 8 * fq;
        if (u.pm != last_pm) { last_pm = u.pm;
#pragma unroll
            for (int ai = 0; ai < 2; ++ai)
#pragma unroll
                for (int m = 0; m < 4; ++m) rs[ai][m] = row_rstd(ssq, row0 + ai * HALF + m * 16, fq); }
#pragma unroll
        for (int ai = 0; ai < 2; ++ai)
#pragma unroll
            for (int m = 0; m < 4; ++m) { const int row = row0 + ai * HALF + m * 16; const float r = rs[ai][m];
#pragma unroll
                for (int bj = 0; bj < 2; ++bj) { const f32x4 v0 = acc[ai][bj][m][0] * r, v1 = acc[ai][bj][m][1] * r;
                    u32x4 w; w.x = cvt_pk_bf16(v0[0], v0[1]); w.y = cvt_pk_bf16(v0[2], v0[3]); w.z = cvt_pk_bf16(v1[0], v1[1]); w.w = cvt_pk_bf16(v1[2], v1[3]);
                    *(u32x4*)(P + (size_t)row * ldc + col0 + bj * HALF) = w; } }
    }
};
struct EpiResid {
    static constexpr bool PERM = true, AFTER_DRAIN = false;
    const float* Xin; float* Xout; bf16_t* XB; float* ssq; float f;
    __device__ __forceinline__ void operator()(const f32x4 (&acc)[2][2][4][2], const Unit& u, int wr, int wc, int fr, int fq) const {
        const int row0 = u.pm * BM + wr * 64 + fr, col0 = u.pn * BM + wc * 32 + 8 * fq;
#pragma unroll
        for (int ai = 0; ai < 2; ++ai) {
            u32x4 xb[4][2];
            if (!Xin) {
#pragma unroll
                for (int m = 0; m < 4; ++m)
#pragma unroll
                    for (int bj = 0; bj < 2; ++bj) xb[m][bj] = *(const u32x4*)(XB + (size_t)(row0 + ai * HALF + m * 16) * 2048 + col0 + bj * HALF);
            }
#pragma unroll
            for (int m = 0; m < 4; ++m) { const int row = row0 + ai * HALF + m * 16; float ss = 0.f;
#pragma unroll
                for (int bj = 0; bj < 2; ++bj) { const size_t off = (size_t)row * 2048 + col0 + bj * HALF;
                    f32x4 x0, x1;
                    if (Xin) { x0 = *(const f32x4*)(Xin + off); x1 = *(const f32x4*)(Xin + off + 4); }
                    else { const u32x4 w = xb[m][bj];
                        x0 = (f32x4){__uint_as_float(w.x << 16), __uint_as_float(w.x & 0xffff0000u), __uint_as_float(w.y << 16), __uint_as_float(w.y & 0xffff0000u)};
                        x1 = (f32x4){__uint_as_float(w.z << 16), __uint_as_float(w.z & 0xffff0000u), __uint_as_float(w.w << 16), __uint_as_float(w.w & 0xffff0000u)}; }
                    x0 = x0 + acc[ai][bj][m][0] * f; x1 = x1 + acc[ai][bj][m][1] * f;
                    if (Xout) { *(f32x4*)(Xout + off) = x0; *(f32x4*)(Xout + off + 4) = x1; }
                    if (!Xout) { u32x4 w; w.x = cvt_pk_bf16(x0[0], x0[1]); w.y = cvt_pk_bf16(x0[2], x0[3]); w.z = cvt_pk_bf16(x1[0], x1[1]); w.w = cvt_pk_bf16(x1[2], x1[3]);
                        *(u32x4*)(XB + off) = w; }
                    ss += ((x0[0] * x0[0] + x0[1] * x0[1]) + (x0[2] * x0[2] + x0[3] * x0[3])) + ((x1[0] * x1[0] + x1[1] * x1[1]) + (x1[2] * x1[2] + x1[3] * x1[3])); }
                ss += __shfl_xor(ss, 16); ss += __shfl_xor(ss, 32);
                if (fq == 0 && !Xout) ssq[(size_t)row * 32 + u.pn * 4 + wc] = ss; }
        }
    }
};
struct MkvOrder {
    int c;
    __device__ __forceinline__ bool next(int i, Unit& u) const { if (i != 0 || c >= 8) return false; u.pm = c >> 2; u.pn = c; return true; }
    __device__ __forceinline__ void a_ready(const Unit&) const {}
    __device__ __forceinline__ void done(const Unit&) const {}
};
template <class Epi, class Sched, bool ALIGN_EPI = false, bool SP2 = false>
__device__ __forceinline__ void gemm_phase(PG8_LAS unsigned char* lds, const Gemm g, const Sched& S, const Epi& E) {
    int tid_ = threadIdx.x; asm volatile("" : "+v"(tid_));
    const int tid = tid_, wid = __builtin_amdgcn_readfirstlane(tid >> 6), lane = tid & 63, wr = wid >> 2, wc = wid & 3, fr = lane & 15, fq = lane >> 4;
    const int K = g.K, nt = K / BK;
    unsigned voffA[2], voffB[2];
#pragma unroll
    for (int i = 0; i < 2; ++i) { int R, C; stage_rc(tid * 16 + i * 8192, R, C); const int Rb = Epi::PERM ? ((R & ~31) + perm32(R & 31)) : R;
        voffA[i] = (unsigned)(R * K + C) * 2u; voffB[i] = (unsigned)(Rb * K + C) * 2u; }
    const size_t kstep = (size_t)(BK * 2);
    const size_t hstep = (size_t)HALF * K * 2;
    const size_t tstep = 2 * hstep;
    const unsigned ldsw = (unsigned)wid * 1024u;
    const int aoff = lds_byte(wr * 64 + fr, fq * 8), boff = lds_byte(wc * 32 + fr, fq * 8);
#define PG8_SA(b, h) (((b) * 2 + (h)) * HTB)
#define PG8_SB(b, h) ((4 + (b) * 2 + (h)) * HTB)
#define PG8_STAGE(bufoff, gbase, voff) do { _Pragma("unroll") for (int _i = 0; _i < 2; ++_i) \
        __builtin_amdgcn_global_load_lds((const unsigned*)((const char*)(gbase) + (voff)[_i]), (PG8_LAS unsigned*)(lds + (bufoff) + ldsw + _i * 8192), 16, 0, 0); } while (0)
#define PG8_LDA(dst, b, h) do { _Pragma("unroll") for (int m = 0; m < 4; ++m) _Pragma("unroll") for (int k = 0; k < 2; ++k) dst[m][k] = *(const PG8_LAS bf16x8*)(lds + PG8_SA(b, h) + aoff + m * 2048 + k * 1024); } while (0)
#define PG8_LDB(dst, b, h) do { _Pragma("unroll") for (int n = 0; n < 2; ++n) _Pragma("unroll") for (int k = 0; k < 2; ++k) dst[n][k] = *(const PG8_LAS bf16x8*)(lds + PG8_SB(b, h) + boff + n * 2048 + k * 1024); } while (0)
#define PG8_MMA(ai, bj, At, Bt) do { __builtin_amdgcn_s_setprio(1); _Pragma("unroll") for (int m = 0; m < 4; ++m) _Pragma("unroll") for (int n = 0; n < 2; ++n) _Pragma("unroll") for (int k = 0; k < 2; ++k) \
        acc[ai][bj][m][n] = __builtin_amdgcn_mfma_f32_16x16x32_bf16(Bt[n][k], At[m][k], acc[ai][bj][m][n], 0, 0, 0); __builtin_amdgcn_s_setprio(0); } while (0)
#define PG8_WAIT_V(n) asm volatile("s_waitcnt vmcnt(" #n ")" ::: "memory")
#define PG8_WAIT_L(n) asm volatile("s_waitcnt lgkmcnt(" #n ")" ::: "memory")
#define PG8_BAR __builtin_amdgcn_s_barrier()
#define PG8_SCHED __builtin_amdgcn_sched_barrier(0)
    Unit cur, nxt; int ui = 0;
    if (!S.next(0, cur)) return;
    f32x4 acc[2][2][4][2];
#pragma unroll
    for (int a = 0; a < 2; ++a)
#pragma unroll
        for (int b = 0; b < 2; ++b)
#pragma unroll
            for (int m = 0; m < 4; ++m)
#pragma unroll
                for (int n = 0; n < 2; ++n) acc[a][b][m][n] = (f32x4){0.f, 0.f, 0.f, 0.f};
    bf16x8 At[4][2], B0[2][2], B1[2][2];
    const char* cA = (const char*)g.A + (size_t)cur.pm * tstep; const char* cB = (const char*)g.Bt + (size_t)cur.pn * tstep;
    S.a_ready(cur);
    if constexpr (SP2) {
        PG8_STAGE(PG8_SB(0, 0), cB, voffB); PG8_STAGE(PG8_SB(0, 1), cB + hstep, voffB); PG8_STAGE(PG8_SA(0, 0), cA, voffA); PG8_STAGE(PG8_SA(0, 1), cA + hstep, voffA);
        if (wr == 1) PG8_BAR;
        PG8_WAIT_V(2); PG8_BAR;
        PG8_STAGE(PG8_SB(1, 0), cB + kstep, voffB); PG8_STAGE(PG8_SA(1, 0), cA + kstep, voffA); PG8_STAGE(PG8_SB(1, 1), cB + hstep + kstep, voffB);
        PG8_WAIT_V(6); PG8_BAR;
    } else {
        PG8_STAGE(PG8_SB(0, 0), cB, voffB); PG8_STAGE(PG8_SA(0, 0), cA, voffA); PG8_STAGE(PG8_SB(0, 1), cB + hstep, voffB); PG8_STAGE(PG8_SA(0, 1), cA + hstep, voffA);
        if (wr == 1) PG8_BAR;
        PG8_WAIT_V(4); PG8_BAR;
        PG8_STAGE(PG8_SB(1, 0), cB + kstep, voffB); PG8_STAGE(PG8_SA(1, 0), cA + kstep, voffA); PG8_STAGE(PG8_SB(1, 1), cB + hstep + kstep, voffB);
        PG8_WAIT_V(6); PG8_BAR;
    }
    for (;;) {
        const bool has_next = S.next(ui + 1, nxt);
        const char* nA = has_next ? (const char*)g.A + (size_t)nxt.pm * tstep : cA; const char* nB = has_next ? (const char*)g.Bt + (size_t)nxt.pn * tstep : cB;
        for (int t = 0; t < nt; t += 2) {
            const bool last = (t == nt - 2);
            const char* a1 = cA + (size_t)(t + 1) * kstep;
            const char* a2 = last ? nA : cA + (size_t)(t + 2) * kstep; const char* b2 = last ? nB : cB + (size_t)(t + 2) * kstep;
            const char* a3 = a2 + kstep; const char* b3 = b2 + kstep;
            if (last && has_next) S.a_ready(nxt);
            if constexpr (SP2) {
            PG8_LDB(B0, 0, 0); PG8_LDB(B1, 0, 1); PG8_SCHED; PG8_LDA(At, 0, 0); PG8_STAGE(PG8_SA(1, 1), a1 + hstep, voffA);
            PG8_WAIT_V(8); PG8_WAIT_L(0); PG8_BAR; PG8_MMA(0, 0, At, B0); PG8_MMA(0, 1, At, B1); PG8_BAR; PG8_SCHED;
            PG8_LDA(At, 0, 1); PG8_STAGE(PG8_SB(0, 0), b2, voffB); PG8_STAGE(PG8_SB(0, 1), b2 + hstep, voffB); PG8_STAGE(PG8_SA(0, 0), a2, voffA);
            PG8_WAIT_V(8); PG8_WAIT_L(0); PG8_BAR; PG8_MMA(1, 0, At, B0); PG8_MMA(1, 1, At, B1); PG8_BAR; PG8_SCHED;
            PG8_LDB(B0, 1, 0); PG8_LDB(B1, 1, 1); PG8_SCHED; PG8_LDA(At, 1, 0); PG8_STAGE(PG8_SA(0, 1), a2 + hstep, voffA);
            PG8_WAIT_V(8); PG8_WAIT_L(0); PG8_BAR; PG8_MMA(0, 0, At, B0); PG8_MMA(0, 1, At, B1); PG8_BAR; PG8_SCHED;
            PG8_LDA(At, 1, 1); PG8_STAGE(PG8_SB(1, 0), b3, voffB); PG8_STAGE(PG8_SB(1, 1), b3 + hstep, voffB); PG8_STAGE(PG8_SA(1, 0), a3, voffA);
            PG8_WAIT_V(8); PG8_WAIT_L(0); PG8_BAR; PG8_MMA(1, 0, At, B0); PG8_MMA(1, 1, At, B1); PG8_BAR; PG8_SCHED;
            } else {
            PG8_LDB(B0, 0, 0); PG8_SCHED; PG8_LDA(At, 0, 0); PG8_STAGE(PG8_SA(1, 1), a1 + hstep, voffA);
            PG8_WAIT_L(8); PG8_BAR; PG8_WAIT_L(0); PG8_MMA(0, 0, At, B0); PG8_BAR; PG8_SCHED;
            PG8_LDB(B1, 0, 1); PG8_STAGE(PG8_SB(0, 0), b2, voffB);
            PG8_BAR; PG8_WAIT_L(0); PG8_MMA(0, 1, At, B1); PG8_BAR;
            PG8_LDA(At, 0, 1); PG8_STAGE(PG8_SA(0, 0), a2, voffA);
            PG8_BAR; PG8_WAIT_L(0); PG8_MMA(1, 0, At, B0); PG8_BAR; PG8_SCHED;
            PG8_STAGE(PG8_SB(0, 1), b2 + hstep, voffB);
            PG8_WAIT_V(6); PG8_BAR; PG8_MMA(1, 1, At, B1); PG8_BAR;
            PG8_LDB(B0, 1, 0); PG8_SCHED; PG8_LDA(At, 1, 0); PG8_STAGE(PG8_SA(0, 1), a2 + hstep, voffA);
            PG8_WAIT_L(8); PG8_BAR; PG8_WAIT_L(0); PG8_MMA(0, 0, At, B0); PG8_BAR; PG8_SCHED;
            PG8_LDB(B1, 1, 1); PG8_STAGE(PG8_SB(1, 0), b3, voffB);
            PG8_BAR; PG8_WAIT_L(0); PG8_MMA(0, 1, At, B1); PG8_BAR;
            PG8_LDA(At, 1, 1); PG8_STAGE(PG8_SA(1, 0), a3, voffA);
            PG8_BAR; PG8_WAIT_L(0); PG8_MMA(1, 0, At, B0); PG8_BAR; PG8_SCHED;
            PG8_STAGE(PG8_SB(1, 1), b3 + hstep, voffB);
            PG8_WAIT_V(6); PG8_BAR; PG8_MMA(1, 1, At, B1); PG8_BAR;
            }
        }
        if constexpr (ALIGN_EPI) { if (wr == 0) PG8_BAR; }
        if constexpr (!Epi::AFTER_DRAIN) { E(acc, cur, wr, wc, fr, fq); S.done(cur); }
        if (!has_next) break;
#pragma unroll
        for (int a = 0; a < 2; ++a)
#pragma unroll
            for (int b = 0; b < 2; ++b)
#pragma unroll
                for (int m = 0; m < 4; ++m)
#pragma unroll
                    for (int n = 0; n < 2; ++n) acc[a][b][m][n] = (f32x4){0.f, 0.f, 0.f, 0.f};
        cur = nxt; cA = nA; cB = nB; ++ui;
        if constexpr (ALIGN_EPI) { if (wr == 1) PG8_BAR; }
    }
    PG8_WAIT_V(0);
    if constexpr (!ALIGN_EPI) { if (wr == 0) PG8_BAR; }
    PG8_BAR;
    if constexpr (Epi::AFTER_DRAIN) { E.fused(acc, cur, wr, wc, fr, fq, lds, wid, lane); S.done(cur); }
#undef PG8_SA
#undef PG8_SB
#undef PG8_STAGE
#undef PG8_LDA
#undef PG8_LDB
#undef PG8_MMA
#undef PG8_WAIT_V
#undef PG8_WAIT_L
#undef PG8_BAR
#undef PG8_SCHED
}
}

#define LAS __attribute__((address_space(3)))
typedef unsigned short bf16_t;
typedef short bf16x8 __attribute__((ext_vector_type(8)));
typedef short s16x4 __attribute__((ext_vector_type(4)));
typedef float f32x4 __attribute__((ext_vector_type(4)));
typedef float f32x2 __attribute__((ext_vector_type(2)));
typedef float f32x16 __attribute__((ext_vector_type(16)));
typedef unsigned u32x4 __attribute__((ext_vector_type(4)));
typedef unsigned u32x2 __attribute__((ext_vector_type(2)));
typedef __bf16 bf16x2_t __attribute__((ext_vector_type(2)));

constexpr int SEQ = 16384, DM = 2048, DFF = 5632, INW = 5120, NH = 8, HD = 128, NBLK = 64, BLKSZ = 256;
#ifndef EN_MASK
#define EN_MASK 0x1ff
#endif
constexpr bool EN_P0 = EN_MASK & 1, EN_P1 = EN_MASK & 2, EN_GU = EN_MASK & 4, EN_RES = EN_MASK & 8, EN_PROJ = EN_MASK & 16, EN_PRE = EN_MASK & 32, EN_GATE = EN_MASK & 64, EN_SEL = EN_MASK & 128, EN_OWN = EN_MASK & 256;
#ifndef MK_DUP
#define MK_DUP 0
#endif
constexpr int NPH = 22;
#ifndef MK_COOP
#define MK_COOP 1
#endif
constexpr size_t MiB = 1u << 20;
constexpr size_t WS_CNT = 0;
constexpr size_t WS_BAR = 16 * 1024;
constexpr size_t WS_KMEAN = 64 * 1024;
constexpr size_t WS_SSQ = 1 * MiB;
constexpr size_t WS_ROPE = 4 * MiB;
constexpr size_t WS_MEMB = 12 * MiB;
constexpr size_t WS_MKV = 14 * MiB;
constexpr size_t WS_ML = 18 * MiB;
constexpr size_t WS_WT = 22 * MiB;
constexpr size_t WT_LAYER = 160 * MiB, WT_GU1 = 0, WT_D1 = 44 * MiB, WT_IN = 66 * MiB, WT_OUT = 86 * MiB, WT_GU2 = 94 * MiB, WT_D2 = 138 * MiB;
constexpr size_t WS_XB = 350 * MiB;
constexpr size_t WS_LIST = WS_XB, WS_VT = WS_XB + 32 * MiB;
constexpr size_t WS_H = 414 * MiB;
constexpr size_t WS_MIX = 590 * MiB;
constexpr size_t WS_PART = 654 * MiB;
constexpr size_t WS_END = 750 * MiB;
constexpr int LDS_BYTES = 147456;
constexpr int KS_STRIDE = 272, VT_STRIDE = 528, LDS_KS = 0, LDS_VT = 256 * KS_STRIDE, LDS_MISC = 139264;
static_assert(LDS_VT + 128 * VT_STRIDE <= LDS_MISC, "lds map");

#define TID_LOCALS int tid_ = threadIdx.x; asm volatile("" : "+v"(tid_)); const int tid = tid_, lane = tid & 63, wave = __builtin_amdgcn_readfirstlane(tid >> 6), r32 = lane & 31, hi = lane >> 5; (void)r32; (void)hi; (void)wave; (void)lane;
struct Args { const void* in[19]; float* out; unsigned char* ws; float inv_freq[64]; int ph_lo, ph_hi; };

__device__ __forceinline__ unsigned cvtpk(float lo, float hi) { f32x2 v = {lo, hi}; bf16x2_t b = __builtin_convertvector(v, bf16x2_t); return __builtin_bit_cast(unsigned, b); }
__device__ __forceinline__ float bflo(unsigned w) { return __uint_as_float(w << 16); }
__device__ __forceinline__ float bfhi(unsigned w) { return __uint_as_float(w & 0xffff0000u); }
__device__ __forceinline__ float wave_sum(float v) {
#pragma unroll
    for (int o = 1; o < 64; o <<= 1) v += __shfl_xor(v, o);
    return v;
}
__device__ __forceinline__ int crow(int r, int hi) { return (r & 3) + 8 * (r >> 2) + 4 * hi; }
#define MFMA32(a, b, c) __builtin_amdgcn_mfma_f32_32x32x16_bf16((a), (b), (c), 0, 0, 0)

__device__ __forceinline__ void tr_item(const float* W, int K, int N, bf16_t* WT, const float* gain, int perm, LAS float* scr, int item, int lane) {
    const int nblk = N / 64, kb = item / nblk, nb = item % nblk, k0 = 64 * kb, n0 = 64 * nb, lr = lane >> 4, c4 = lane & 15;
    f32x4 v[16];
#pragma unroll
    for (int i = 0; i < 16; ++i) v[i] = *(const f32x4*)(W + (size_t)(k0 + lr + 4 * i) * N + n0 + 4 * c4);
    if (gain) {
#pragma unroll
        for (int i = 0; i < 16; ++i) v[i] = v[i] * gain[k0 + lr + 4 * i];
    }
#pragma unroll
    for (int i = 0; i < 16; ++i)
#pragma unroll
        for (int e = 0; e < 4; ++e) scr[(lr + 4 * i) * 65 + 4 * c4 + e] = v[i][e];
    asm volatile("s_waitcnt lgkmcnt(0)" ::: "memory");
    const int c = lane & 7;
#pragma unroll
    for (int j = 0; j < 8; ++j) { const int n = (lane >> 3) + 8 * j; const LAS float* s = scr + (8 * c) * 65 + n;
        u32x4 o; o.x = cvtpk(s[0 * 65], s[1 * 65]); o.y = cvtpk(s[2 * 65], s[3 * 65]); o.z = cvtpk(s[4 * 65], s[5 * 65]); o.w = cvtpk(s[6 * 65], s[7 * 65]);
        const int ncol = n0 + n; int drow = ncol;
        if (perm) { const int hf = ncol >= DFF ? 1 : 0, jj = ncol - hf * DFF; drow = 256 * (jj >> 7) + 128 * hf + (jj & 127); }
        *(u32x4*)(WT + (size_t)drow * K + k0 + 8 * c) = o; }
    asm volatile("s_waitcnt lgkmcnt(0)" ::: "memory");
}

template <bool CAUSAL>
__device__ __forceinline__ void attn_tile(const LAS unsigned char* Ks, const LAS unsigned char* Vts, const bf16x8 (&qf)[8], int qi, int r32, int hi, f32x16 (&O)[4], float& m2, float& l) {
    const float c = 0.08838834764831845f * 1.4426950408889634f;
    float m = -1.0e30f, lsum = 0.f;
#pragma unroll
    for (int d = 0; d < 4; ++d)
#pragma unroll
        for (int r = 0; r < 16; ++r) O[d][r] = 0.f;
#pragma unroll 1
    for (int hf = 0; hf < 2; ++hf) {
        f32x16 S[4];
#pragma unroll
        for (int s = 0; s < 4; ++s) {
            f32x16 a;
#pragma unroll
            for (int r = 0; r < 16; ++r) a[r] = 0.f;
            const LAS unsigned char* kp = Ks + (128 * hf + 32 * s + r32) * KS_STRIDE + 16 * hi;
#pragma unroll
            for (int d0 = 0; d0 < 8; ++d0) { const bf16x8 kf = *(const LAS bf16x8*)(kp + 32 * d0); a = MFMA32(kf, qf[d0], a); }
            S[s] = a;
            __builtin_amdgcn_sched_barrier(0);
        }
        float mx = -1.0e30f;
#pragma unroll
        for (int s = 0; s < 4; ++s)
#pragma unroll
            for (int r = 0; r < 16; ++r) { float v = S[s][r]; if (CAUSAL) { if (128 * hf + 32 * s + crow(r, hi) > qi) v = -INFINITY; S[s][r] = v; } mx = fmaxf(mx, v); }
        mx = fmaxf(mx, __shfl_xor(mx, 32));
        const float mn = fmaxf(m, mx * c), alpha = __builtin_amdgcn_exp2f(m - mn);
        m = mn; lsum *= alpha;
#pragma unroll
        for (int d = 0; d < 4; ++d)
#pragma unroll
            for (int r = 0; r < 16; ++r) O[d][r] *= alpha;
#pragma unroll
        for (int s = 0; s < 4; ++s)
#pragma unroll
            for (int r = 0; r < 16; ++r) { const float p = __builtin_amdgcn_exp2f(S[s][r] * c - mn); S[s][r] = p; lsum += p; }
#pragma unroll
        for (int s = 0; s < 4; ++s)
#pragma unroll
            for (int j = 0; j < 2; ++j) {
                u32x4 pw; pw.x = cvtpk(S[s][8 * j + 0], S[s][8 * j + 1]); pw.y = cvtpk(S[s][8 * j + 2], S[s][8 * j + 3]); pw.z = cvtpk(S[s][8 * j + 4], S[s][8 * j + 5]); pw.w = cvtpk(S[s][8 * j + 6], S[s][8 * j + 7]);
                const bf16x8 pf = __builtin_bit_cast(bf16x8, pw);
#pragma unroll
                for (int d = 0; d < 4; ++d) {
                    const LAS unsigned char* vp = Vts + (32 * d + r32) * VT_STRIDE + (128 * hf + 32 * s + 16 * j + 4 * hi) * 2;
                    const s16x4 lo = *(const LAS s16x4*)vp, h4 = *(const LAS s16x4*)(vp + 16);
                    const bf16x8 vf = __builtin_shufflevector(lo, h4, 0, 1, 2, 3, 4, 5, 6, 7);
                    O[d] = MFMA32(vf, pf, O[d]);
                }
                __builtin_amdgcn_sched_barrier(0);
            }
    }
    lsum += __shfl_xor(lsum, 32);
    m2 = m; l = lsum;
}
__device__ __forceinline__ void stage_kv(LAS unsigned char* lds, const bf16_t* Kg, int kpitch, const bf16_t* Vtg, int tid) {
#pragma unroll
    for (int i = 0; i < 8; ++i) { const int c = tid + 512 * i, row = c >> 4, ch = c & 15; *(LAS u32x4*)(lds + LDS_KS + row * KS_STRIDE + ch * 16) = *(const u32x4*)(Kg + (size_t)row * kpitch + ch * 8); }
#pragma unroll
    for (int i = 0; i < 8; ++i) { const int c = tid + 512 * i, row = c >> 5, ch = c & 31; *(LAS u32x4*)(lds + LDS_VT + row * VT_STRIDE + ch * 16) = *(const u32x4*)(Vtg + (size_t)row * 256 + ch * 8); }
}
__device__ __forceinline__ void store_orow(bf16_t* orow, const f32x16 (&O)[4], float sc, int hi, bool st) {
#pragma unroll
    for (int d = 0; d < 4; ++d)
#pragma unroll
        for (int k = 0; k < 2; ++k) {
            const unsigned x0 = cvtpk(O[d][8 * k + 0] * sc, O[d][8 * k + 1] * sc), x1 = cvtpk(O[d][8 * k + 2] * sc, O[d][8 * k + 3] * sc);
            const unsigned y0 = cvtpk(O[d][8 * k + 4] * sc, O[d][8 * k + 5] * sc), y1 = cvtpk(O[d][8 * k + 6] * sc, O[d][8 * k + 7] * sc);
            const auto r0 = __builtin_amdgcn_permlane32_swap(x0, y0, false, false), r1 = __builtin_amdgcn_permlane32_swap(x1, y1, false, false);
            u32x4 w; w.x = r0[0]; w.y = r1[0]; w.z = r0[1]; w.w = r1[1];
            if (st) *(u32x4*)(orow + 32 * d + 16 * k + 8 * hi) = w;
        }
}
__device__ __forceinline__ void addmul_prow(f32x16 (&O)[4], const bf16_t* pr, float wt, int hi) {
#pragma unroll
    for (int d = 0; d < 4; ++d)
#pragma unroll
        for (int k = 0; k < 2; ++k) {
            const u32x4 w = *(const u32x4*)(pr + 32 * d + 16 * k + 8 * hi);
            const auto r0 = __builtin_amdgcn_permlane32_swap(w.x, w.z, false, false), r1 = __builtin_amdgcn_permlane32_swap(w.y, w.w, false, false);
            O[d][8 * k + 0] += wt * bflo(r0[0]); O[d][8 * k + 1] += wt * bfhi(r0[0]); O[d][8 * k + 2] += wt * bflo(r1[0]); O[d][8 * k + 3] += wt * bfhi(r1[0]);
            O[d][8 * k + 4] += wt * bflo(r0[1]); O[d][8 * k + 5] += wt * bfhi(r0[1]); O[d][8 * k + 6] += wt * bflo(r1[1]); O[d][8 * k + 7] += wt * bfhi(r1[1]);
        }
}

__device__ __forceinline__ void norm_rope_block(bf16_t* base  , bf16_t* obase, int opitch, const float* gain, const int* positions, const f32x2* rope, int tok0, bool do_mean, float* kmean, LAS unsigned char* lds, int tid) {
    const int row = tid >> 1, hf = tid & 1, tok = tok0 + row, lane = tid & 63, wave = tid >> 6;
    bf16_t* p = base + (size_t)row * INW;
    u32x4 a[4], c[4];
#pragma unroll
    for (int i = 0; i < 4; ++i) { a[i] = *(const u32x4*)(p + 32 * hf + 8 * i); c[i] = *(const u32x4*)(p + 64 + 32 * hf + 8 * i); }
    float x1[32], x2[32]; float ss = 0.f;
#pragma unroll
    for (int i = 0; i < 4; ++i)
#pragma unroll
        for (int e = 0; e < 4; ++e) { x1[8 * i + 2 * e] = bflo(a[i][e]); x1[8 * i + 2 * e + 1] = bfhi(a[i][e]); x2[8 * i + 2 * e] = bflo(c[i][e]); x2[8 * i + 2 * e + 1] = bfhi(c[i][e]); }
#pragma unroll
    for (int i = 0; i < 32; ++i) ss += x1[i] * x1[i] + x2[i] * x2[i];
    ss += __shfl_xor(ss, 1);
    const float rstd = 1.0f / sqrtf(ss * (1.0f / 128.0f) + 1e-6f);
    const f32x2* rt = rope + (size_t)tok * 64 + 32 * hf;
#pragma unroll
    for (int i = 0; i < 32; ++i) { const float n1 = x1[i] * rstd * gain[32 * hf + i], n2 = x2[i] * rstd * gain[64 + 32 * hf + i]; const f32x2 cs = rt[i];
        x1[i] = n1 * cs.x - n2 * cs.y; x2[i] = n2 * cs.x + n1 * cs.y; }
#pragma unroll
    for (int i = 0; i < 4; ++i) { u32x4 w, v;
#pragma unroll
        for (int e = 0; e < 4; ++e) { w[e] = cvtpk(x1[8 * i + 2 * e], x1[8 * i + 2 * e + 1]); v[e] = cvtpk(x2[8 * i + 2 * e], x2[8 * i + 2 * e + 1]); }
        bf16_t* po = obase + (size_t)row * opitch; *(u32x4*)(po + 32 * hf + 8 * i) = w; *(u32x4*)(po + 64 + 32 * hf + 8 * i) = v; }
    if (do_mean) {
        LAS float* tile = (LAS float*)lds;
#pragma unroll
        for (int i = 0; i < 8; ++i) { *(LAS f32x4*)(tile + row * 132 + 32 * hf + 4 * i) = (f32x4){x1[4 * i], x1[4 * i + 1], x1[4 * i + 2], x1[4 * i + 3]};
                                      *(LAS f32x4*)(tile + row * 132 + 64 + 32 * hf + 4 * i) = (f32x4){x2[4 * i], x2[4 * i + 1], x2[4 * i + 2], x2[4 * i + 3]}; }
        __syncthreads();
        { const int d = tid & 127, q4 = tid >> 7; float sacc = 0.f;
#pragma unroll 16
          for (int r = 0; r < 64; ++r) sacc += tile[(64 * q4 + r) * 132 + d];
          LAS float* part = (LAS float*)(lds + LDS_MISC);
          part[q4 * 128 + d] = sacc; }
        __syncthreads();
        if (tid < 128) { LAS float* part = (LAS float*)(lds + LDS_MISC); kmean[tid] = ((part[tid] + part[128 + tid]) + (part[256 + tid] + part[384 + tid])) * (1.0f / 256.0f); }
        __syncthreads();
    }
}

#define XB_TMO      128
#define XB_XCNT(j)  (256  + 64 * (j))
#define XB_XSUB(j)  (1280 + 64 * (j))
#define XB_XGEN(j)  (2304 + 64 * (j))
#define XB_TOP      3328
#define XB_TOPGEN   3392
#define XCD_BAR_WORDS 3456
#define XB_SPIN_CAP (1u << 18)

__device__ __forceinline__ unsigned xb_ld(unsigned* p)              { return __hip_atomic_load(p, __ATOMIC_RELAXED, __HIP_MEMORY_SCOPE_AGENT); }
__device__ __forceinline__ unsigned xb_add(unsigned* p, unsigned v) { return __hip_atomic_fetch_add(p, v, __ATOMIC_RELAXED, __HIP_MEMORY_SCOPE_AGENT); }
__device__ __forceinline__ unsigned xb_xcc_id() { return (unsigned)__builtin_amdgcn_s_getreg((3 << 11) | 20) & 0xFu; }
#define XB_SPIN(cond, bar) do { unsigned _sp = 0; while (cond) { __builtin_amdgcn_s_sleep(1); \
    if ((++_sp & 255u) == 0u) { if (xb_ld(&(bar)[XB_TMO])) break; if (_sp > XB_SPIN_CAP) { atomicAdd(&(bar)[XB_TMO], 1u); break; } } } } while (0)

struct XcdBarrier {
    unsigned* bar; unsigned x;
    volatile LAS unsigned* st;
};

__device__ __forceinline__ XcdBarrier xcd_barrier_post(unsigned* bar, volatile LAS unsigned* st) {
    XcdBarrier b; b.bar = bar; b.x = xb_xcc_id(); b.st = st;
    if (threadIdx.x == 0) (void)xb_add(&bar[XB_XCNT(b.x)], 1u);
    return b;
}
__device__ __forceinline__ void xcd_barrier_complete(unsigned* bar, unsigned x, unsigned& nloc, unsigned& nx) {
    const unsigned G = gridDim.x * gridDim.y * gridDim.z;
    unsigned sum, cnt, mine, sp = 0u;
    for (;;) {
        sum = 0u; cnt = 0u; mine = 0u;
#pragma unroll
        for (unsigned j = 0; j < 16; ++j) { const unsigned c = xb_ld(&bar[XB_XCNT(j)]); sum += c; cnt += (c > 0u) ? 1u : 0u; mine = (j == x) ? c : mine; }
        if (sum == G) break;
        __builtin_amdgcn_s_sleep(1);
        if ((++sp & 255u) == 0u) { if (xb_ld(&bar[XB_TMO])) break; if (sp > XB_SPIN_CAP) { atomicAdd(&bar[XB_TMO], 1u); break; } }
    }
    nloc = mine > 0u ? mine : 1u; nx = cnt > 0u ? cnt : 1u;
}

__device__ __forceinline__ void xcd_barrier(const XcdBarrier& b) {
    asm volatile("s_waitcnt vmcnt(0)" ::: "memory");
    __syncthreads();
    if (threadIdx.x == 0) {
        unsigned* bar = b.bar;
        __builtin_amdgcn_s_waitcnt(0);
        unsigned nloc = b.st[0], nx = b.st[1];
        if (nloc == 0u) { xcd_barrier_complete(bar, b.x, nloc, nx); b.st[0] = nloc; b.st[1] = nx; }
        const unsigned old = xb_add(&bar[XB_XSUB(b.x)], 1u);
        const unsigned gen = old / nloc;
        if (old + 1u == (gen + 1u) * nloc) {
            __builtin_amdgcn_fence(__ATOMIC_RELEASE, "agent");
            asm volatile("s_waitcnt vmcnt(0)" ::: "memory");
            const unsigned og = xb_add(&bar[XB_TOP], 1u);
            const unsigned tg = og / nx;
            if (og + 1u == (tg + 1u) * nx) xb_add(&bar[XB_TOPGEN], 1u);
            else XB_SPIN(xb_ld(&bar[XB_TOPGEN]) == tg, bar);
            __builtin_amdgcn_fence(__ATOMIC_ACQUIRE, "agent");
            xb_add(&bar[XB_XGEN(b.x)], 1u);
            asm volatile("s_waitcnt vmcnt(0)" ::: "memory");
        } else {
            XB_SPIN(xb_ld(&bar[XB_XGEN(b.x)]) == gen, bar);
            __builtin_amdgcn_fence(__ATOMIC_ACQUIRE, "agent");
            asm volatile("s_waitcnt vmcnt(0)" ::: "memory");
        }
    }
    __syncthreads();
}

__global__ void __launch_bounds__(512, 2) mk_fwd(Args a) {
    extern __shared__ __attribute__((aligned(16))) unsigned char lds_raw[];
    LAS unsigned char* lds = (LAS unsigned char*)lds_raw;
    cg::grid_group grid = cg::this_grid();
    volatile LAS unsigned* bst = (volatile LAS unsigned*)(lds + LDS_BYTES - 16);
    if (threadIdx.x < 2) bst[threadIdx.x] = 0u;
    __syncthreads();
    XcdBarrier bar; bar.bar = nullptr; bar.x = 0; bar.st = bst;
    int redo_ = 0;
    for (int ph = a.ph_lo; ph < a.ph_hi; ++ph) {
        int bid_ = blockIdx.x, G_ = gridDim.x; asm volatile("" : "+s"(bid_), "+s"(G_));
        const int G = G_, bid = bid_;
        unsigned char* ws = a.ws; asm volatile("" : "+s"(ws));
        const float* x_in = (const float*)a.in[0]; const float* mem = (const float*)a.in[1]; const int* positions = (const int*)a.in[2];
        float* X = a.out;
        unsigned* CNT = (unsigned*)(ws + WS_CNT); float* KMEAN = (float*)(ws + WS_KMEAN); float* SSQ = (float*)(ws + WS_SSQ); f32x2* ROPE = (f32x2*)(ws + WS_ROPE);
        bf16_t* MEMB = (bf16_t*)(ws + WS_MEMB); float* MKV = (float*)(ws + WS_MKV); f32x2* ML = (f32x2*)(ws + WS_ML);
        bf16_t* XB = (bf16_t*)(ws + WS_XB); unsigned* LIST = (unsigned*)a.out; bf16_t* VT = (bf16_t*)((unsigned char*)a.out + 32 * MiB);
        bf16_t* H = (bf16_t*)(ws + WS_H); bf16_t* PROJ = (bf16_t*)(ws + WS_H); bf16_t* MIX = (bf16_t*)(ws + WS_MIX); bf16_t* PART = (bf16_t*)(ws + WS_PART);
        bf16_t* WT_MKV = (bf16_t*)(ws + WS_WT);

        const int s_ = ph >= 2 ? (ph - 2) % 10 : -1;
        const int nrep = (((MK_DUP & 1) && ph == 0) || ((MK_DUP & 2) && (s_ == 5 || s_ == 6)) || ((MK_DUP & 4) && (s_ == 0 || s_ == 8)) || ((MK_DUP & 8) && s_ == 2) || ((MK_DUP & 16) && ph == 1) || ((MK_DUP & 32) && ph == 3) || ((MK_DUP & 64) && (s_ == 1 || s_ == 7 || s_ == 9)) || ((MK_DUP & 128) && s_ == 3)) ? 2 : 1;
        for (int rep = 0; rep < nrep; ++rep) {
        if (rep) __syncthreads();
        if (EN_P0 && ph == 0) {
            TID_LOCALS
            LAS float* scr = (LAS float*)(lds + wave * 16640);
            const int gw = bid * 8 + wave, NGW = G * 8;
            constexpr int I_MKV = 32 * 16;
            for (int it = gw; it < 2 * I_MKV; it += NGW) { const int l = it >= I_MKV ? 1 : 0, r = it - l * I_MKV;
                tr_item((const float*)a.in[12] + (size_t)l * DM * 1024, DM, 1024, WT_MKV + (size_t)l * 1024 * DM, nullptr, 0, scr, r, lane); }
            for (int mr = gw; mr < 512; mr += NGW) {
                const int ml = mr >> 8;
                const f32x4* xr = (const f32x4*)(mem + (size_t)(mr & 255) * DM) + lane;
                f32x4 v[8]; float ss = 0.f;
#pragma unroll
                for (int j = 0; j < 8; ++j) { v[j] = xr[64 * j]; ss += (v[j][0] * v[j][0] + v[j][1] * v[j][1]) + (v[j][2] * v[j][2] + v[j][3] * v[j][3]); }
                ss = wave_sum(ss);
                const float rstd = 1.0f / sqrtf(ss * (1.0f / DM) + 1e-6f); const f32x4* gn = (const f32x4*)((const float*)a.in[11] + ml * DM) + lane;
                u32x2* o = (u32x2*)(MEMB + (size_t)mr * DM) + lane;
#pragma unroll
                for (int j = 0; j < 8; ++j) { const f32x4 g = gn[64 * j]; o[64 * j] = (u32x2){cvtpk(v[j][0] * rstd * g[0], v[j][1] * rstd * g[1]), cvtpk(v[j][2] * rstd * g[2], v[j][3] * rstd * g[3])}; }
            }
            if (bid == 0) { CNT[tid] = 0u; CNT[512 + tid] = 0u; CNT[1024 + tid] = 0u; unsigned* bw = (unsigned*)(ws + WS_BAR); for (int i = tid; i < XCD_BAR_WORDS; i += 512) bw[i] = 0u; }
        } else if (EN_P1 && ph == 1 && bid < 8) {
            pg8::Gemm g{MEMB, WT_MKV, 512, 2048, DM}; pg8::MkvOrder S{bid}; pg8::EpiF32 E{MKV, 2048};
            pg8::gemm_phase<pg8::EpiF32, pg8::MkvOrder, true, true>(lds, g, S, E);
        } else if (EN_P0 && ph == 1) {
            TID_LOCALS
            LAS float* scr = (LAS float*)(lds + wave * 16640);
            const int gw = (bid - 8) * 8 + wave, NGW = (G - 8) * 8;
            constexpr int I_GU = 32 * 176, I_D = 88 * 32, I_IN = 32 * 80, I_OUT = 32 * 32, I_LAYER = 2 * I_GU + 2 * I_D + I_IN + I_OUT;
            for (int it = gw; it < 2 * I_LAYER; it += NGW) {
                const int l = it >= I_LAYER ? 1 : 0; int r = it - l * I_LAYER;
                bf16_t* wl = (bf16_t*)(ws + WS_WT + 8 * MiB + (size_t)l * WT_LAYER);
                if (r < I_GU) { tr_item((const float*)a.in[4] + (size_t)l * DM * 2 * DFF, DM, 2 * DFF, (bf16_t*)((unsigned char*)wl + WT_GU1), (const float*)a.in[3] + l * DM, 1, scr, r, lane); continue; } r -= I_GU;
                if (r < I_GU) { tr_item((const float*)a.in[17] + (size_t)l * DM * 2 * DFF, DM, 2 * DFF, (bf16_t*)((unsigned char*)wl + WT_GU2), (const float*)a.in[16] + l * DM, 1, scr, r, lane); continue; } r -= I_GU;
                if (r < I_D) { tr_item((const float*)a.in[5] + (size_t)l * DFF * DM, DFF, DM, (bf16_t*)((unsigned char*)wl + WT_D1), nullptr, 0, scr, r, lane); continue; } r -= I_D;
                if (r < I_D) { tr_item((const float*)a.in[18] + (size_t)l * DFF * DM, DFF, DM, (bf16_t*)((unsigned char*)wl + WT_D2), nullptr, 0, scr, r, lane); continue; } r -= I_D;
                if (r < I_IN) { tr_item((const float*)a.in[7] + (size_t)l * DM * INW, DM, INW, (bf16_t*)((unsigned char*)wl + WT_IN), (const float*)a.in[6] + l * DM, 0, scr, r, lane); continue; } r -= I_IN;
                tr_item((const float*)a.in[15] + (size_t)l * DM * DM, DM, DM, (bf16_t*)((unsigned char*)wl + WT_OUT), nullptr, 0, scr, r, lane);
            }
            for (int i = (bid - 8) * 512 + tid; i < SEQ * 64; i += (G - 8) * 512) {
                const int t = i >> 6, fi = i & 63; const float ang = (float)positions[t] * a.inv_freq[fi];
                double rev = (double)ang * 0.15915494309189535; rev -= __builtin_rint(rev); const float fr = (float)rev;
                ROPE[i] = (f32x2){__builtin_amdgcn_cosf(fr), __builtin_amdgcn_sinf(fr)};
            }
            for (int row = gw; row < SEQ; row += NGW) {
                const f32x4* xr = (const f32x4*)(x_in + (size_t)row * DM) + lane;
                f32x4 v[8]; float ss = 0.f;
#pragma unroll
                for (int j = 0; j < 8; ++j) { v[j] = xr[64 * j]; ss += (v[j][0] * v[j][0] + v[j][1] * v[j][1]) + (v[j][2] * v[j][2] + v[j][3] * v[j][3]); }
                ss = wave_sum(ss);
                u32x2* o = (u32x2*)(XB + (size_t)row * DM) + lane;
#pragma unroll
                for (int j = 0; j < 8; ++j) o[64 * j] = (u32x2){cvtpk(v[j][0], v[j][1]), cvtpk(v[j][2], v[j][3])};
                if (lane < 32) SSQ[(size_t)row * 32 + lane] = lane == 0 ? ss : 0.f;
            }
        } else {
            const int l = (ph - 2) / 10, s = (ph - 2) % 10;
            unsigned char* wl = ws + WS_WT + 8 * MiB + (size_t)l * WT_LAYER;
            if (EN_GU && (s == 0 || s == 8)) {
                pg8::Gemm g{XB, (const bf16_t*)(wl + (s == 0 ? WT_GU1 : WT_GU2)), SEQ, 2 * DFF, DM}; pg8::StaticOrder S; S.init(SEQ, 2 * DFF, G, bid);
                pg8::EpiSwiglu E{H, SSQ, {{0.f, 0.f, 0.f, 0.f}, {0.f, 0.f, 0.f, 0.f}}, -1};
                pg8::gemm_phase<pg8::EpiSwiglu, pg8::StaticOrder, true, true>(lds, g, S, E);
            } else if (EN_RES && (s == 1 || s == 7 || s == 9)) {
                const bool isout = (s == 7);
                pg8::Gemm g{isout ? MIX : H, (const bf16_t*)(wl + (s == 1 ? WT_D1 : (isout ? WT_OUT : WT_D2))), SEQ, DM, isout ? DM : DFF}; pg8::StaticOrder S; S.init(SEQ, DM, G, bid);
                pg8::EpiResid E{(l == 0 && s == 1) ? x_in : nullptr, (ph == NPH - 1) ? X : nullptr, XB, SSQ, ((MK_DUP & 64) && rep == 0) ? 0.0f : (isout ? 1.0f : 0.5f)};
                pg8::gemm_phase<pg8::EpiResid, pg8::StaticOrder, true, true>(lds, g, S, E);
            } else if (EN_PROJ && s == 2) {
                pg8::Gemm g{XB, (const bf16_t*)(wl + WT_IN), SEQ, INW, DM}; pg8::StaticOrder S; S.init(SEQ, INW, G, bid);
                pg8::EpiProj E{PROJ, INW, SSQ, {{0.f, 0.f, 0.f, 0.f}, {0.f, 0.f, 0.f, 0.f}}, -1};
                pg8::gemm_phase<pg8::EpiProj, pg8::StaticOrder, true, true>(lds, g, S, E);
            } else if (EN_PRE && s == 3) {
                for (int it = bid; it < 1024; it += G) {
                    const int w = it & 255, kk = it >> 8, b = w & 63, sl = (w >> 6) + 4 * kk, tok0 = 256 * b;
                    if (sl < 8) {
                        TID_LOCALS
                        const int h = sl;
                        {
                        const bool dummy_ = (MK_DUP & 128) && rep == 0; bf16_t* ob_ = dummy_ ? MIX + (size_t)tok0 * DM + 128 * h : nullptr;
                        norm_rope_block(PROJ + (size_t)tok0 * INW + 128 * h, dummy_ ? ob_ : PROJ + (size_t)tok0 * INW + 128 * h, dummy_ ? DM : INW, (const float*)a.in[8] + l * HD, positions, ROPE, tok0, false, nullptr, lds, tid);
                        norm_rope_block(PROJ + (size_t)tok0 * INW + 1024 + 128 * h, dummy_ ? ob_ : PROJ + (size_t)tok0 * INW + 1024 + 128 * h, dummy_ ? DM : INW, (const float*)a.in[9] + l * HD, positions, ROPE, tok0, true, KMEAN + (size_t)(h * 64 + b) * 128, lds, tid);
                        }
                        const int dch = tid & 15, tg = tid >> 4;
                        const bf16_t* vsrc = PROJ + (size_t)(tok0 + 8 * tg) * INW + 2048 + 128 * h + 8 * dch;
                        u32x4 rw[8];
#pragma unroll
                        for (int e = 0; e < 8; ++e) rw[e] = *(const u32x4*)(vsrc + (size_t)e * INW);
                        bf16_t* vdst = VT + ((size_t)(h * 64 + b) * 128 + 8 * dch) * 256 + 8 * tg;
#pragma unroll
                        for (int c = 0; c < 8; ++c) { u32x4 o;
#pragma unroll
                            for (int e2 = 0; e2 < 4; ++e2) { const unsigned lo = rw[2 * e2][c >> 1], hh = rw[2 * e2 + 1][c >> 1];
                                o[e2] = (c & 1) ? ((lo >> 16) | (hh & 0xffff0000u)) : ((lo & 0xffffu) | (hh << 16)); }
                            *(u32x4*)(vdst + (size_t)c * 256) = o; }
                    } else if (sl < 12) {
                        TID_LOCALS
                        const int g = sl - 8, ch = tid & 15, tl = tid >> 4, c0 = 128 * g + 8 * ch, t0 = tok0 + 8 * tl;
                        const float* cw = (const float*)a.in[10] + l * 3 * 512 + c0;
                        float w0[8], w1[8], w2[8];
#pragma unroll
                        for (int e = 0; e < 8; ++e) { w0[e] = cw[e]; w1[e] = cw[512 + e]; w2[e] = cw[1024 + e]; }
                        float um2[8], um1[8];
#pragma unroll
                        for (int e = 0; e < 8; ++e) { um2[e] = 0.f; um1[e] = 0.f; }
                        if (t0 >= 2) {
                            const u32x4 c2 = *(const u32x4*)(PROJ + (size_t)(t0 - 2) * INW + 3584 + c0), x2 = *(const u32x4*)(PROJ + (size_t)(t0 - 2) * INW + 4096 + c0);
                            const u32x4 c1 = *(const u32x4*)(PROJ + (size_t)(t0 - 1) * INW + 3584 + c0), x1 = *(const u32x4*)(PROJ + (size_t)(t0 - 1) * INW + 4096 + c0);
#pragma unroll
                            for (int e = 0; e < 4; ++e) { um2[2 * e] = bflo(c2[e]) * bflo(x2[e]); um2[2 * e + 1] = bfhi(c2[e]) * bfhi(x2[e]); um1[2 * e] = bflo(c1[e]) * bflo(x1[e]); um1[2 * e + 1] = bfhi(c1[e]) * bfhi(x1[e]); }
                        }
#pragma unroll
                        for (int k = 0; k < 8; ++k) { const size_t ro = (size_t)(t0 + k) * INW;
                            const u32x4 cb = *(const u32x4*)(PROJ + ro + 3072 + c0), cc = *(const u32x4*)(PROJ + ro + 3584 + c0), cx = *(const u32x4*)(PROJ + ro + 4096 + c0);
                            float uc[8], y[8];
#pragma unroll
                            for (int e = 0; e < 4; ++e) { uc[2 * e] = bflo(cc[e]) * bflo(cx[e]); uc[2 * e + 1] = bfhi(cc[e]) * bfhi(cx[e]); }
#pragma unroll
                            for (int e = 0; e < 8; ++e) y[e] = w0[e] * um2[e] + w1[e] * um1[e] + w2[e] * uc[e];
                            u32x4 o;
#pragma unroll
                            for (int e = 0; e < 4; ++e) o[e] = cvtpk(y[2 * e] * bflo(cb[e]), y[2 * e + 1] * bfhi(cb[e]));
                            *(u32x4*)(MIX + (size_t)(t0 + k) * DM + 1024 + c0) = o;
#pragma unroll
                            for (int e = 0; e < 8; ++e) { um2[e] = um1[e]; um1[e] = uc[e]; } }
                    } else {
                        TID_LOCALS
                        const int hm = sl - 12;
                        { const int m = tid >> 1, hf = tid & 1;
                          const f32x4* kr = (const f32x4*)(MKV + (size_t)(256 * l + m) * 2048 + 1024 * l + 128 * hm + 64 * hf);
                          const f32x4* gk = (const f32x4*)((const float*)a.in[14] + l * HD + 64 * hf);
                          f32x4 v[16]; float ss = 0.f;
#pragma unroll
                          for (int i = 0; i < 16; ++i) { v[i] = kr[i]; ss += (v[i][0] * v[i][0] + v[i][1] * v[i][1]) + (v[i][2] * v[i][2] + v[i][3] * v[i][3]); }
                          ss += __shfl_xor(ss, 1);
                          const float rstd = 1.0f / sqrtf(ss * (1.0f / 128.0f) + 1e-6f);
#pragma unroll
                          for (int i = 0; i < 8; ++i) { const f32x4 g0 = gk[2 * i], g1 = gk[2 * i + 1]; const f32x4 p0 = v[2 * i] * rstd * g0, p1 = v[2 * i + 1] * rstd * g1;
                              u32x4 o; o.x = cvtpk(p0[0], p0[1]); o.y = cvtpk(p0[2], p0[3]); o.z = cvtpk(p1[0], p1[1]); o.w = cvtpk(p1[2], p1[3]);
                              *(LAS u32x4*)(lds + LDS_KS + m * KS_STRIDE + 128 * hf + 16 * i) = o; }
                          const f32x4* vr = kr + 128;
#pragma unroll
                          for (int i = 0; i < 16; ++i) { const f32x4 vv = vr[i];
#pragma unroll
                              for (int e = 0; e < 4; ++e) *(LAS bf16_t*)(lds + LDS_VT + (64 * hf + 4 * i + e) * VT_STRIDE + 2 * m) = (bf16_t)(cvtpk(vv[e], 0.f) & 0xffffu); }
                        }
                        __syncthreads();
                        const int tok = tok0 + 32 * wave + r32;
                        const bf16_t* qrow = PROJ + (size_t)tok * INW + 4608 + 128 * hm + 8 * hi;
                        const float* gq = (const float*)a.in[13] + l * HD + 8 * hi;
                        u32x4 qr[8]; float ss = 0.f;
#pragma unroll
                        for (int d0 = 0; d0 < 8; ++d0) { qr[d0] = *(const u32x4*)(qrow + 16 * d0);
#pragma unroll
                            for (int e = 0; e < 4; ++e) { const float lo = bflo(qr[d0][e]), hh = bfhi(qr[d0][e]); ss += lo * lo + hh * hh; } }
                        ss += __shfl_xor(ss, 32);
                        const float rstd = 1.0f / sqrtf(ss * (1.0f / 128.0f) + 1e-6f);
                        bf16x8 qf[8];
#pragma unroll
                        for (int d0 = 0; d0 < 8; ++d0) { u32x4 o;
#pragma unroll
                            for (int e = 0; e < 4; ++e) o[e] = cvtpk(bflo(qr[d0][e]) * rstd * gq[16 * d0 + 2 * e], bfhi(qr[d0][e]) * rstd * gq[16 * d0 + 2 * e + 1]);
                            qf[d0] = __builtin_bit_cast(bf16x8, o); }
                        f32x16 O[4]; float m2, ll;
                        attn_tile<false>(lds + LDS_KS, lds + LDS_VT, qf, 0, r32, hi, O, m2, ll);
                        store_orow(MIX + (size_t)tok * DM + 1536 + 128 * hm, O, 1.0f / ll, hi, true);
                        __syncthreads();
                    }
                }
            } else if (EN_GATE && s == 4) {
                for (int it = bid; it < 512; it += G) {
                    TID_LOCALS
                    const int h = it & 7, qc = it >> 3;
                    if (qc == 0) continue;
                    { const int j = tid >> 3, dc = (tid & 7) * 16; const f32x4* src = (const f32x4*)(KMEAN + ((size_t)h * 64 + j) * 128 + dc);
                      u32x4 hw[2], lw[2];
#pragma unroll
                      for (int i = 0; i < 4; ++i) { const f32x4 v = src[i]; float r_[4];
#pragma unroll
                          for (int e = 0; e < 4; ++e) { const unsigned hb = cvtpk(v[e], 0.f) & 0xffffu; r_[e] = v[e] - __uint_as_float(hb << 16); }
                          hw[i >> 1][2 * (i & 1)] = cvtpk(v[0], v[1]); hw[i >> 1][2 * (i & 1) + 1] = cvtpk(v[2], v[3]);
                          lw[i >> 1][2 * (i & 1)] = cvtpk(r_[0], r_[1]); lw[i >> 1][2 * (i & 1) + 1] = cvtpk(r_[2], r_[3]); }
                      *(LAS u32x4*)(lds + j * KS_STRIDE + dc * 2) = hw[0]; *(LAS u32x4*)(lds + j * KS_STRIDE + dc * 2 + 16) = hw[1];
                      *(LAS u32x4*)(lds + 64 * KS_STRIDE + j * KS_STRIDE + dc * 2) = lw[0]; *(LAS u32x4*)(lds + 64 * KS_STRIDE + j * KS_STRIDE + dc * 2 + 16) = lw[1]; }
                    __syncthreads();
                    const int tok = 256 * qc + 32 * wave + r32;
                    const bf16_t* qrow = PROJ + (size_t)tok * INW + 128 * h + 8 * hi;
                    bf16x8 qf[8];
#pragma unroll
                    for (int d0 = 0; d0 < 8; ++d0) qf[d0] = *(const bf16x8*)(qrow + 16 * d0);
                    float b0 = -INFINITY, b1 = -INFINITY, b2 = -INFINITY; int i0 = 0, i1 = 0, i2 = 0;
#pragma unroll
                    for (int jt = 0; jt < 2; ++jt) {
                        if (jt == 0 || qc > 32) {
                            f32x16 g;
#pragma unroll
                            for (int r = 0; r < 16; ++r) g[r] = 0.f;
                            const LAS unsigned char* kp = lds + (32 * jt + r32) * KS_STRIDE + 16 * hi;
#pragma unroll
                            for (int d0 = 0; d0 < 8; ++d0) { const bf16x8 kh = *(const LAS bf16x8*)(kp + 32 * d0), kl = *(const LAS bf16x8*)(kp + 64 * KS_STRIDE + 32 * d0);
                                g = MFMA32(kh, qf[d0], g); g = MFMA32(kl, qf[d0], g); }
#pragma unroll
                            for (int r = 0; r < 16; ++r) { const int j = 32 * jt + crow(r, hi); const float v = g[r];
                                if (j < qc) {
                                    if (v > b0) { b2 = b1; i2 = i1; b1 = b0; i1 = i0; b0 = v; i0 = j; }
                                    else if (v > b1) { b2 = b1; i2 = i1; b1 = v; i1 = j; }
                                    else if (v > b2) { b2 = v; i2 = j; } } }
                        }
                    }
                    { const float o0 = __shfl_xor(b0, 32), o1 = __shfl_xor(b1, 32), o2 = __shfl_xor(b2, 32); const int p0 = __shfl_xor(i0, 32), p1 = __shfl_xor(i1, 32), p2 = __shfl_xor(i2, 32);
#define MK_INS(v, j) do { const float v_ = (v); const int j_ = (j); \
                          if (v_ > b0 || (v_ == b0 && j_ < i0)) { b2 = b1; i2 = i1; b1 = b0; i1 = i0; b0 = v_; i0 = j_; } \
                          else if (v_ > b1 || (v_ == b1 && j_ < i1)) { b2 = b1; i2 = i1; b1 = v_; i1 = j_; } \
                          else if (v_ > b2 || (v_ == b2 && j_ < i2)) { b2 = v_; i2 = j_; } } while (0)
                      MK_INS(o0, p0); MK_INS(o1, p1); MK_INS(o2, p2);
#undef MK_INS
                    }
                    LAS unsigned* cntl = (LAS unsigned*)(lds + LDS_MISC); LAS unsigned* basel = cntl + 64;
                    if (tid < 64) cntl[tid] = 0u;
                    __syncthreads();
                    unsigned r0 = 0u, r1 = 0u, r2 = 0u;
                    if (hi == 0) { r0 = atomicAdd((unsigned*)(cntl + i0), 1u); if (qc > 1) r1 = atomicAdd((unsigned*)(cntl + i1), 1u); if (qc > 2) r2 = atomicAdd((unsigned*)(cntl + i2), 1u); }
                    __syncthreads();
                    if (tid < 64) { const unsigned n = cntl[tid]; basel[tid] = n ? atomicAdd(CNT + l * 512 + h * 64 + tid, n) : 0u; }
                    __syncthreads();
                    if (hi == 0) {
                        LIST[(size_t)(h * 64 + i0) * SEQ + basel[i0] + r0] = ((unsigned)tok << 2) | 0u;
                        if (qc > 1) LIST[(size_t)(h * 64 + i1) * SEQ + basel[i1] + r1] = ((unsigned)tok << 2) | 1u;
                        if (qc > 2) LIST[(size_t)(h * 64 + i2) * SEQ + basel[i2] + r2] = ((unsigned)tok << 2) | 2u;
                    }
                    __syncthreads();
                }
            } else if (EN_SEL && s == 5) {
                LAS int* pre = (LAS int*)(lds + LDS_MISC); LAS int* wtot = (LAS int*)(lds + LDS_MISC + 2048);
                { TID_LOCALS
                  const int mycnt = (int)CNT[l * 512 + tid];
                  int v = (mycnt + 255) >> 8;
#pragma unroll
                  for (int o = 1; o < 64; o <<= 1) { const int t = __shfl_up(v, o); if (lane >= o) v += t; }
                  if (lane == 63) wtot[wave] = v;
                  __syncthreads();
                  int add = 0;
#pragma unroll
                  for (int w = 0; w < 8; ++w) add += (w < wave) ? wtot[w] : 0;
                  pre[tid] = v + add;
                  __syncthreads(); }
                const int total = pre[511];
                const int vcu = (G % 8 == 0) ? (bid % 8) * (G / 8) + bid / 8 : bid;
                for (int it = vcu; it < total; it += G) {
                    TID_LOCALS
                    int lo = 0, hh = 511;
                    while (lo < hh) { const int mid = (lo + hh) >> 1; if (pre[mid] > it) hh = mid; else lo = mid + 1; }
                    const int p = lo, chunk = it - (p ? pre[p - 1] : 0), h = p >> 6, b = p & 63;
                    const int pc = (int)CNT[l * 512 + p];
                    stage_kv(lds, PROJ + (size_t)(256 * b) * INW + 1024 + 128 * h, INW, VT + (size_t)(h * 64 + b) * 128 * 256, tid);
                    __syncthreads();
                    const int e = chunk * 256 + 32 * wave + r32; const bool valid = e < pc;
                    const unsigned ent = LIST[(size_t)p * SEQ + (valid ? e : 0)]; const int tok = (int)(ent >> 2), slot = (int)(ent & 3u);
                    const bf16_t* qrow = PROJ + (size_t)tok * INW + 128 * h + 8 * hi;
                    bf16x8 qf[8];
#pragma unroll
                    for (int d0 = 0; d0 < 8; ++d0) qf[d0] = *(const bf16x8*)(qrow + 16 * d0);
                    f32x16 O[4]; float m2, ll;
                    attn_tile<false>(lds + LDS_KS, lds + LDS_VT, qf, 0, r32, hi, O, m2, ll);
                    { const size_t pi = ((size_t)h * SEQ + tok) * 3 + slot;
                      store_orow(PART + pi * 128, O, 1.0f / ll, hi, valid);
                      if (valid && hi == 0) ML[pi] = (f32x2){m2, ll}; }
                    __syncthreads();
                }
            } else if (EN_OWN && s == 6) {
                for (int it = bid; it < 512; it += G) {
                    TID_LOCALS
                    const int h = it & 7, b = it >> 3;
                    stage_kv(lds, PROJ + (size_t)(256 * b) * INW + 1024 + 128 * h, INW, VT + (size_t)(h * 64 + b) * 128 * 256, tid);
                    __syncthreads();
                    const int qi = 32 * wave + r32, tok = 256 * b + qi;
                    const bf16_t* qrow = PROJ + (size_t)tok * INW + 128 * h + 8 * hi;
                    bf16x8 qf[8];
#pragma unroll
                    for (int d0 = 0; d0 < 8; ++d0) qf[d0] = *(const bf16x8*)(qrow + 16 * d0);
                    f32x16 O[4]; float m2, ll;
                    attn_tile<true>(lds + LDS_KS, lds + LDS_VT, qf, qi, r32, hi, O, m2, ll);
                    const int nsel = b < 3 ? b : 3; const size_t pi = ((size_t)h * SEQ + tok) * 3;
                    float M = m2;
#pragma unroll 1
                    for (int t = 0; t < nsel; ++t) M = fmaxf(M, ML[pi + t].x);
                    const float wo = __builtin_amdgcn_exp2f(m2 - M); float den = ll * wo;
#pragma unroll
                    for (int d = 0; d < 4; ++d)
#pragma unroll
                        for (int r = 0; r < 16; ++r) O[d][r] *= wo;
#pragma unroll 1
                    for (int t = 0; t < nsel; ++t) { const f32x2 ml = ML[pi + t]; const float wt = ml.y * __builtin_amdgcn_exp2f(ml.x - M); den += wt; addmul_prow(O, PART + (pi + t) * 128, wt, hi); }
                    store_orow(MIX + (size_t)tok * DM + 128 * h, O, 1.0f / den, hi, true);
                    __syncthreads();
                }
            }
        }
        }
#if MK_COOP
        if (ph + 1 < a.ph_hi) {
            if (ph == a.ph_lo) { grid.sync(); bar = xcd_barrier_post((unsigned*)(a.ws + WS_BAR), bst); }
            else xcd_barrier(bar);
        }
#endif
        if ((MK_DUP & 256) && s_ == 3 && redo_ == 0) { redo_ = 1; ph -= 2; } else if (s_ == 4) redo_ = 0;
    }
}

extern "C" void kernel_launch(void* const* d_in, const int* in_sizes, int n_in, void* d_out, int out_size, void* d_ws, size_t ws_size, hipStream_t stream) {
    static int grid = 0;
    if (grid == 0) {
        if (n_in != 19 || out_size != SEQ * DM || ws_size < WS_END) { fprintf(stderr, "kernel_launch: unexpected shapes (n_in %d, out %d, ws %zu); nothing launched\n", n_in, out_size, ws_size); grid = -1; return; }
        int dev = 0, cus = 0, per_cu = 0;
        if (hipGetDevice(&dev) != hipSuccess || hipDeviceGetAttribute(&cus, hipDeviceAttributeMultiprocessorCount, dev) != hipSuccess) { grid = -1; return; }
        if (hipFuncSetAttribute((const void*)mk_fwd, hipFuncAttributeMaxDynamicSharedMemorySize, LDS_BYTES) != hipSuccess) { fprintf(stderr, "kernel_launch: hipFuncSetAttribute failed\n"); grid = -1; return; }
        if (hipOccupancyMaxActiveBlocksPerMultiprocessor(&per_cu, (const void*)mk_fwd, 512, LDS_BYTES) != hipSuccess || per_cu < 1) { fprintf(stderr, "kernel_launch: occupancy query gave %d\n", per_cu); per_cu = 1; }
        (void)hipGetLastError();
        grid = cus * per_cu;
        fprintf(stderr, "kernel_launch: grid %d (%d CUs x %d)\n", grid, cus, per_cu);
    }
    if (grid < 0) return;
    Args a{};
    for (int i = 0; i < 19; ++i) a.in[i] = d_in[i];
    a.out = (float*)d_out; a.ws = (unsigned char*)d_ws;
    for (int i = 0; i < 64; ++i) a.inv_freq[i] = (float)pow(10000.0, -(double)(2 * i) / 128.0);
#if MK_COOP
    a.ph_lo = 0; a.ph_hi = NPH;
    void* args[] = {&a};
    const hipError_t e = hipLaunchCooperativeKernel((const void*)mk_fwd, dim3(grid), dim3(512), args, LDS_BYTES, stream);
    if (e != hipSuccess) fprintf(stderr, "kernel_launch: cooperative launch failed: %s (grid %d)\n", hipGetErrorString(e), grid);
#else
    for (int ph = 0; ph < NPH; ++ph) { a.ph_lo = ph; a.ph_hi = ph + 1; hipLaunchKernelGGL(mk_fwd, dim3(grid), dim3(512), LDS_BYTES, stream, a); }
#endif
}
```

```cpp
#include <hip/hip_runtime.h>
#include <hip/hip_cooperative_groups.h>
#include <cstdio>
#include <cstdint>
#include <cmath>
namespace cg = cooperative_groups;
namespace pg8 {
#define PG8_LAS __attribute__((address_space(3)))
typedef unsigned short bf16_t;
typedef short bf16x8 __attribute__((ext_vector_type(8)));
typedef float f32x4 __attribute__((ext_vector_type(4)));
typedef unsigned u32x4 __attribute__((ext_vector_type(4)));
constexpr int BM = 256, BK = 64, HALF = 128, HTB = HALF * BK * 2  , STAGE_BYTES = 8 * HTB, NXCD = 8, WGM = 8;

__host__ __device__ __forceinline__ int lds_byte(int r, int c) { const int st = (r >> 4) * 2 + (c >> 5), rr = r & 15, cc = c & 31, ob = rr * 64 + cc * 2; return st * 1024 + (ob ^ (((ob >> 9) & 1) << 5)); }
__host__ __device__ __forceinline__ void stage_rc(int b, int& R, int& C) { const int st = b / 1024, sb = b % 1024, swz = sb ^ (((sb >> 9) & 1) << 5); R = (st >> 1) * 16 + swz / 64; C = (st & 1) * 32 + (swz % 64) / 2; }
__host__ __device__ __forceinline__ int perm32(int rho) { const int n = rho >> 4, i = rho & 15; return 8 * (i >> 2) + 4 * n + (i & 3); }

struct Unit { int pm, pn; };
struct Gemm { const bf16_t* A; const bf16_t* Bt; int M, N, K; };

struct StaticOrder {
    int nM, nN, nwg, G, c;
    __host__ __device__ void init(int M, int N, int G_, int c_) { nM = M / BM; nN = N / BM; nwg = nM * nN; G = G_; c = c_; }
    __host__ __device__ bool next(int i, Unit& u) const {
        const long L = (long)i * G + c; if (L >= nwg) return false;
        int wgid = (int)L; { const int q = nwg / NXCD, r = nwg % NXCD, xcd = wgid % NXCD, off = wgid / NXCD; wgid = (xcd < r ? xcd * (q + 1) : r * (q + 1) + (xcd - r) * q) + off; }
        const int nig = WGM * nN, gid = wgid / nig, fm = gid * WGM, gsz = (nM - fm) < WGM ? (nM - fm) : WGM;
        u.pm = fm + ((wgid % nig) % gsz); u.pn = (wgid % nig) / gsz; return true;
    }
    __device__ __forceinline__ void a_ready(const Unit&) const {}
    __device__ __forceinline__ void done(const Unit&) const {}
};

__device__ __forceinline__ unsigned cvt_pk_bf16(float lo, float hi) { unsigned r; asm volatile("v_cvt_pk_bf16_f32 %0, %1, %2" : "=v"(r) : "v"(lo), "v"(hi)); return r; }
typedef float f32x2 __attribute__((ext_vector_type(2)));
struct EpiF32 {
    static constexpr bool PERM = false, AFTER_DRAIN = false;
    float* C; int ldc;
    __device__ __forceinline__ void operator()(const f32x4 (&acc)[2][2][4][2], const Unit& u, int wr, int wc, int fr, int fq) const {
        const int row0 = u.pm * BM + wr * 64 + fr, col0 = u.pn * BM + wc * 32 + 4 * fq;
#pragma unroll
        for (int ai = 0; ai < 2; ++ai)
#pragma unroll
            for (int m = 0; m < 4; ++m) { float* rowp = C + (size_t)(row0 + ai * HALF + m * 16) * ldc + col0;
#pragma unroll
                for (int bj = 0; bj < 2; ++bj)
#pragma unroll
                    for (int n = 0; n < 2; ++n) *(f32x4*)(rowp + bj * HALF + n * 16) = acc[ai][bj][m][n]; }
    }
};
__device__ __forceinline__ float row_rstd(const float* ssq, int row, int fq) {
    const f32x4* p = (const f32x4*)(ssq + (size_t)row * 32 + fq * 8);
    const f32x4 a = p[0], b = p[1];
    float s = ((a[0] + a[1]) + (a[2] + a[3])) + ((b[0] + b[1]) + (b[2] + b[3]));
    s += __shfl_xor(s, 16); s += __shfl_xor(s, 32);
    return 1.0f / sqrtf(s * (1.0f / 2048.0f) + 1e-6f);
}
__device__ __forceinline__ f32x4 swiglu4(f32x4 g, f32x4 u) {
    f32x4 o;
#pragma unroll
    for (int e = 0; e < 4; ++e) { const float t = __builtin_amdgcn_exp2f(g[e] * -1.4426950408889634f); o[e] = g[e] * __builtin_amdgcn_rcpf(1.0f + t) * u[e]; }
    return o;
}
struct EpiSwiglu {
    static constexpr bool PERM = true, AFTER_DRAIN = false;
    bf16_t* H; const float* ssq; mutable float rs[2][4]; mutable int last_pm;
    __device__ __forceinline__ void operator()(const f32x4 (&acc)[2][2][4][2], const Unit& u, int wr, int wc, int fr, int fq) const {
        const int row0 = u.pm * BM + wr * 64 + fr, col0 = u.pn * HALF + wc * 32 + 8 * fq;
        if (u.pm != last_pm) { last_pm = u.pm;
#pragma unroll
            for (int ai = 0; ai < 2; ++ai)
#pragma unroll
                for (int m = 0; m < 4; ++m) rs[ai][m] = row_rstd(ssq, row0 + ai * HALF + m * 16, fq); }
#pragma unroll
        for (int ai = 0; ai < 2; ++ai)
#pragma unroll
            for (int m = 0; m < 4; ++m) { const int row = row0 + ai * HALF + m * 16; const float r = rs[ai][m];
                const f32x4 h0 = swiglu4(acc[ai][0][m][0] * r, acc[ai][1][m][0] * r), h1 = swiglu4(acc[ai][0][m][1] * r, acc[ai][1][m][1] * r);
                u32x4 w; w.x = cvt_pk_bf16(h0[0], h0[1]); w.y = cvt_pk_bf16(h0[2], h0[3]); w.z = cvt_pk_bf16(h1[0], h1[1]); w.w = cvt_pk_bf16(h1[2], h1[3]);
                *(u32x4*)(H + (size_t)row * 5632 + col0) = w; }
    }
};
struct EpiProj {
    static constexpr bool PERM = true, AFTER_DRAIN = false;
    bf16_t* P; int ldc; const float* ssq; mutable float rs[2][4]; mutable int last_pm;
    __device__ __forceinline__ void operator()(const f32x4 (&acc)[2][2][4][2], const Unit& u, int wr, int wc, int fr, int fq) const {
        const int row0 = u.pm * BM + wr * 64 + fr, col0 = u.pn * BM + wc * 32 + 8 * fq;
        if (u.pm != last_pm) { last_pm = u.pm;
#pragma unroll
            for (int ai = 0; ai < 2; ++ai)
#pragma unroll
                for (int m = 0; m < 4; ++m) rs[ai][m] = row_rstd(ssq, row0 + ai * HALF + m * 16, fq); }
#pragma unroll
        for (int ai = 0; ai < 2; ++ai)
#pragma unroll
            for (int m = 0; m < 4; ++m) { const int row = row0 + ai * HALF + m * 16; const float r = rs[ai][m];
#pragma unroll
                for (int bj = 0; bj < 2; ++bj) { const f32x4 v0 = acc[ai][bj][m][0] * r, v1 = acc[ai][bj][m][1] * r;
                    u32x4 w; w.x = cvt_pk_bf16(v0[0], v0[1]); w.y = cvt_pk_bf16(v0[2], v0[3]); w.z = cvt_pk_bf16(v1[0], v1[1]); w.w = cvt_pk_bf16(v1[2], v1[3]);
                    *(u32x4*)(P + (size_t)row * ldc + col0 + bj * HALF) = w; } }
    }
};
struct EpiResid {
    static constexpr bool PERM = true, AFTER_DRAIN = false;
    const float* Xin; float* Xout; bf16_t* XB; float* ssq; float f;
    __device__ __forceinline__ void operator()(const f32x4 (&acc)[2][2][4][2], const Unit& u, int wr, int wc, int fr, int fq) const {
        const int row0 = u.pm * BM + wr * 64 + fr, col0 = u.pn * BM + wc * 32 + 8 * fq;
#pragma unroll
        for (int ai = 0; ai < 2; ++ai) {
            u32x4 xb[4][2];
            if (!Xin) {
#pragma unroll
                for (int m = 0; m < 4; ++m)
#pragma unroll
                    for (int bj = 0; bj < 2; ++bj) xb[m][bj] = *(const u32x4*)(XB + (size_t)(row0 + ai * HALF + m * 16) * 2048 + col0 + bj * HALF);
            }
#pragma unroll
            for (int m = 0; m < 4; ++m) { const int row = row0 + ai * HALF + m * 16; float ss = 0.f;
#pragma unroll
                for (int bj = 0; bj < 2; ++bj) { const size_t off = (size_t)row * 2048 + col0 + bj * HALF;
                    f32x4 x0, x1;
                    if (Xin) { x0 = *(const f32x4*)(Xin + off); x1 = *(const f32x4*)(Xin + off + 4); }
                    else { const u32x4 w = xb[m][bj];
                        x0 = (f32x4){__uint_as_float(w.x << 16), __uint_as_float(w.x & 0xffff0000u), __uint_as_float(w.y << 16), __uint_as_float(w.y & 0xffff0000u)};
                        x1 = (f32x4){__uint_as_float(w.z << 16), __uint_as_float(w.z & 0xffff0000u), __uint_as_float(w.w << 16), __uint_as_float(w.w & 0xffff0000u)}; }
                    x0 = x0 + acc[ai][bj][m][0] * f; x1 = x1 + acc[ai][bj][m][1] * f;
                    if (Xout) { *(f32x4*)(Xout + off) = x0; *(f32x4*)(Xout + off + 4) = x1; }
                    if (!Xout) { u32x4 w; w.x = cvt_pk_bf16(x0[0], x0[1]); w.y = cvt_pk_bf16(x0[2], x0[3]); w.z = cvt_pk_bf16(x1[0], x1[1]); w.w = cvt_pk_bf16(x1[2], x1[3]);
                        *(u32x4*)(XB + off) = w; }
                    ss += ((x0[0] * x0[0] + x0[1] * x0[1]) + (x0[2] * x0[2] + x0[3] * x0[3])) + ((x1[0] * x1[0] + x1[1] * x1[1]) + (x1[2] * x1[2] + x1[3] * x1[3])); }
                ss += __shfl_xor(ss, 16); ss += __shfl_xor(ss, 32);
                if (fq == 0 && !Xout) ssq[(size_t)row * 32 + u.pn * 4 + wc] = ss; }
        }
    }
};
struct MkvOrder {
    int c;
    __device__ __forceinline__ bool next(int i, Unit& u) const { if (i != 0 || c >= 8) return false; u.pm = c >> 2; u.pn = c; return true; }
    __device__ __forceinline__ void a_ready(const Unit&) const {}
    __device__ __forceinline__ void done(const Unit&) const {}
};
template <class Epi, class Sched, bool ALIGN_EPI = false, bool SP2 = false>
__device__ __forceinline__ void gemm_phase(PG8_LAS unsigned char* lds, const Gemm g, const Sched& S, const Epi& E) {
    int tid_ = threadIdx.x; asm volatile("" : "+v"(tid_));
    const int tid = tid_, wid = __builtin_amdgcn_readfirstlane(tid >> 6), lane = tid & 63, wr = wid >> 2, wc = wid & 3, fr = lane & 15, fq = lane >> 4;
    const int K = g.K, nt = K / BK;
    unsigned voffA[2], voffB[2];
#pragma unroll
    for (int i = 0; i < 2; ++i) { int R, C; stage_rc(tid * 16 + i * 8192, R, C); const int Rb = Epi::PERM ? ((R & ~31) + perm32(R & 31)) : R;
        voffA[i] = (unsigned)(R * K + C) * 2u; voffB[i] = (unsigned)(Rb * K + C) * 2u; }
    const size_t kstep = (size_t)(BK * 2);
    const size_t hstep = (size_t)HALF * K * 2;
    const size_t tstep = 2 * hstep;
    const unsigned ldsw = (unsigned)wid * 1024u;
    const int aoff = lds_byte(wr * 64 + fr, fq * 8), boff = lds_byte(wc * 32 + fr, fq * 8);
#define PG8_SA(b, h) (((b) * 2 + (h)) * HTB)
#define PG8_SB(b, h) ((4 + (b) * 2 + (h)) * HTB)
#define PG8_STAGE(bufoff, gbase, voff) do { _Pragma("unroll") for (int _i = 0; _i < 2; ++_i) \
        __builtin_amdgcn_global_load_lds((const unsigned*)((const char*)(gbase) + (voff)[_i]), (PG8_LAS unsigned*)(lds + (bufoff) + ldsw + _i * 8192), 16, 0, 0); } while (0)
#define PG8_LDA(dst, b, h) do { _Pragma("unroll") for (int m = 0; m < 4; ++m) _Pragma("unroll") for (int k = 0; k < 2; ++k) dst[m][k] = *(const PG8_LAS bf16x8*)(lds + PG8_SA(b, h) + aoff + m * 2048 + k * 1024); } while (0)
#define PG8_LDB(dst, b, h) do { _Pragma("unroll") for (int n = 0; n < 2; ++n) _Pragma("unroll") for (int k = 0; k < 2; ++k) dst[n][k] = *(const PG8_LAS bf16x8*)(lds + PG8_SB(b, h) + boff + n * 2048 + k * 1024); } while (0)
#define PG8_MMA(ai, bj, At, Bt) do { __builtin_amdgcn_s_setprio(1); _Pragma("unroll") for (int m = 0; m < 4; ++m) _Pragma("unroll") for (int n = 0; n < 2; ++n) _Pragma("unroll") for (int k = 0; k < 2; ++k) \
        acc[ai][bj][m][n] = __builtin_amdgcn_mfma_f32_16x16x32_bf16(Bt[n][k], At[m][k], acc[ai][bj][m][n], 0, 0, 0); __builtin_amdgcn_s_setprio(0); } while (0)
#define PG8_WAIT_V(n) asm volatile("s_waitcnt vmcnt(" #n ")" ::: "memory")
#define PG8_WAIT_L(n) asm volatile("s_waitcnt lgkmcnt(" #n ")" ::: "memory")
#define PG8_BAR __builtin_amdgcn_s_barrier()
#define PG8_SCHED __builtin_amdgcn_sched_barrier(0)
    Unit cur, nxt; int ui = 0;
    if (!S.next(0, cur)) return;
    f32x4 acc[2][2][4][2];
#pragma unroll
    for (int a = 0; a < 2; ++a)
#pragma unroll
        for (int b = 0; b < 2; ++b)
#pragma unroll
            for (int m = 0; m < 4; ++m)
#pragma unroll
                for (int n = 0; n < 2; ++n) acc[a][b][m][n] = (f32x4){0.f, 0.f, 0.f, 0.f};
    bf16x8 At[4][2], B0[2][2], B1[2][2];
    const char* cA = (const char*)g.A + (size_t)cur.pm * tstep; const char* cB = (const char*)g.Bt + (size_t)cur.pn * tstep;
    S.a_ready(cur);
    if constexpr (SP2) {
        PG8_STAGE(PG8_SB(0, 0), cB, voffB); PG8_STAGE(PG8_SB(0, 1), cB + hstep, voffB); PG8_STAGE(PG8_SA(0, 0), cA, voffA); PG8_STAGE(PG8_SA(0, 1), cA + hstep, voffA);
        if (wr == 1) PG8_BAR;
        PG8_WAIT_V(2); PG8_BAR;
        PG8_STAGE(PG8_SB(1, 0), cB + kstep, voffB); PG8_STAGE(PG8_SA(1, 0), cA + kstep, voffA); PG8_STAGE(PG8_SB(1, 1), cB + hstep + kstep, voffB);
        PG8_WAIT_V(6); PG8_BAR;
    } else {
        PG8_STAGE(PG8_SB(0, 0), cB, voffB); PG8_STAGE(PG8_SA(0, 0), cA, voffA); PG8_STAGE(PG8_SB(0, 1), cB + hstep, voffB); PG8_STAGE(PG8_SA(0, 1), cA + hstep, voffA);
        if (wr == 1) PG8_BAR;
        PG8_WAIT_V(4); PG8_BAR;
        PG8_STAGE(PG8_SB(1, 0), cB + kstep, voffB); PG8_STAGE(PG8_SA(1, 0), cA + kstep, voffA); PG8_STAGE(PG8_SB(1, 1), cB + hstep + kstep, voffB);
        PG8_WAIT_V(6); PG8_BAR;
    }
    for (;;) {
        const bool has_next = S.next(ui + 1, nxt);
        const char* nA = has_next ? (const char*)g.A + (size_t)nxt.pm * tstep : cA; const char* nB = has_next ? (const char*)g.Bt + (size_t)nxt.pn * tstep : cB;
        for (int t = 0; t < nt; t += 2) {
            const bool last = (t == nt - 2);
            const char* a1 = cA + (size_t)(t + 1) * kstep;
            const char* a2 = last ? nA : cA + (size_t)(t + 2) * kstep; const char* b2 = last ? nB : cB + (size_t)(t + 2) * kstep;
            const char* a3 = a2 + kstep; const char* b3 = b2 + kstep;
            if (last && has_next) S.a_ready(nxt);
            if constexpr (SP2) {
            PG8_LDB(B0, 0, 0); PG8_LDB(B1, 0, 1); PG8_SCHED; PG8_LDA(At, 0, 0); PG8_STAGE(PG8_SA(1, 1), a1 + hstep, voffA);
            PG8_WAIT_V(8); PG8_WAIT_L(0); PG8_BAR; PG8_MMA(0, 0, At, B0); PG8_MMA(0, 1, At, B1); PG8_BAR; PG8_SCHED;
            PG8_LDA(At, 0, 1); PG8_STAGE(PG8_SB(0, 0), b2, voffB); PG8_STAGE(PG8_SB(0, 1), b2 + hstep, voffB); PG8_STAGE(PG8_SA(0, 0), a2, voffA);
            PG8_WAIT_V(8); PG8_WAIT_L(0); PG8_BAR; PG8_MMA(1, 0, At, B0); PG8_MMA(1, 1, At, B1); PG8_BAR; PG8_SCHED;
            PG8_LDB(B0, 1, 0); PG8_LDB(B1, 1, 1); PG8_SCHED; PG8_LDA(At, 1, 0); PG8_STAGE(PG8_SA(0, 1), a2 + hstep, voffA);
            PG8_WAIT_V(8); PG8_WAIT_L(0); PG8_BAR; PG8_MMA(0, 0, At, B0); PG8_MMA(0, 1, At, B1); PG8_BAR; PG8_SCHED;
            PG8_LDA(At, 1, 1); PG8_STAGE(PG8_SB(1, 0), b3, voffB); PG8_STAGE(PG8_SB(1, 1), b3 + hstep, voffB); PG8_STAGE(PG8_SA(1, 0), a3, voffA);
            PG8_WAIT_V(8); PG8_WAIT_L(0); PG8_BAR; PG8_MMA(1, 0, At, B0); PG8_MMA(1, 1, At, B1); PG8_BAR; PG8_SCHED;
            } else {
            PG8_LDB(B0, 0, 0); PG8_SCHED; PG8_LDA(At, 0, 0); PG8_STAGE(PG8_SA(1, 1), a1 + hstep, voffA);
            PG8_WAIT_L(8); PG8_BAR; PG8_WAIT_L(0); PG8_MMA(0, 0, At, B0); PG8_BAR; PG8_SCHED;
            PG8_LDB(B1, 0, 1); PG8_STAGE(PG8_SB(0, 0), b2, voffB);
            PG8_BAR; PG8_WAIT_L(0); PG8_MMA(0, 1, At, B1); PG8_BAR;
            PG8_LDA(At, 0, 1); PG8_STAGE(PG8_SA(0, 0), a2, voffA);
            PG8_BAR; PG8_WAIT_L(0); PG8_MMA(1, 0, At, B0); PG8_BAR; PG8_SCHED;
            PG8_STAGE(PG8_SB(0, 1), b2 + hstep, voffB);
            PG8_WAIT_V(6); PG8_BAR; PG8_MMA(1, 1, At, B1); PG8_BAR;
            PG8_LDB(B0, 1, 0); PG8_SCHED; PG8_LDA(At, 1, 0); PG8_STAGE(PG8_SA(0, 1), a2 + hstep, voffA);
            PG8_WAIT_L(8); PG8_BAR; PG8_WAIT_L(0); PG8_MMA(0, 0, At, B0); PG8_BAR; PG8_SCHED;
            PG8_LDB(B1, 1, 1); PG8_STAGE(PG8_SB(1, 0), b3, voffB);
            PG8_BAR; PG8_WAIT_L(0); PG8_MMA(0, 1, At, B1); PG8_BAR;
            PG8_LDA(At, 1, 1); PG8_STAGE(PG8_SA(1, 0), a3, voffA);
            PG8_BAR; PG8_WAIT_L(0); PG8_MMA(1, 0, At, B0); PG8_BAR; PG8_SCHED;
            PG8_STAGE(PG8_SB(1, 1), b3 + hstep, voffB);
            PG8_WAIT_V(6); PG8_BAR; PG8_MMA(1, 1, At, B1); PG8_BAR;
            }
        }
        if constexpr (ALIGN_EPI) { if (wr == 0) PG8_BAR; }
        if constexpr (!Epi::AFTER_DRAIN) { E(acc, cur, wr, wc, fr, fq); S.done(cur); }
        if (!has_next) break;
#pragma unroll
        for (int a = 0; a < 2; ++a)
#pragma unroll
            for (int b = 0; b < 2; ++b)
#pragma unroll
                for (int m = 0; m < 4; ++m)
#pragma unroll
                    for (int n = 0; n < 2; ++n) acc[a][b][m][n] = (f32x4){0.f, 0.f, 0.f, 0.f};
        cur = nxt; cA = nA; cB = nB; ++ui;
        if constexpr (ALIGN_EPI) { if (wr == 1) PG8_BAR; }
    }
    PG8_WAIT_V(0);
    if constexpr (!ALIGN_EPI) { if (wr == 0) PG8_BAR; }
    PG8_BAR;
    if constexpr (Epi::AFTER_DRAIN) { E.fused(acc, cur, wr, wc, fr, fq, lds, wid, lane); S.done(cur); }
#undef PG8_SA
#undef PG8_SB
#undef PG8_STAGE
#undef PG8_LDA
#undef PG8_LDB
#undef PG8_MMA
#undef PG8_WAIT_V
#undef PG8_WAIT_L
#undef PG8_BAR
#undef PG8_SCHED
}
}

#define LAS __attribute__((address_space(3)))
typedef unsigned short bf16_t;
typedef short bf16x8 __attribute__((ext_vector_type(8)));
typedef short s16x4 __attribute__((ext_vector_type(4)));
typedef float f32x4 __attribute__((ext_vector_type(4)));
typedef float f32x2 __attribute__((ext_vector_type(2)));
typedef float f32x16 __attribute__((ext_vector_type(16)));
typedef unsigned u32x4 __attribute__((ext_vector_type(4)));
typedef unsigned u32x2 __attribute__((ext_vector_type(2)));
typedef __bf16 bf16x2_t __attribute__((ext_vector_type(2)));

constexpr int SEQ = 16384, DM = 2048, DFF = 5632, INW = 5120, NH = 8, HD = 128, NBLK = 64, BLKSZ = 256;
#ifndef EN_MASK
#define EN_MASK 0x1ff
#endif
constexpr bool EN_P0 = EN_MASK & 1, EN_P1 = EN_MASK & 2, EN_GU = EN_MASK & 4, EN_RES = EN_MASK & 8, EN_PROJ = EN_MASK & 16, EN_PRE = EN_MASK & 32, EN_GATE = EN_MASK & 64, EN_SEL = EN_MASK & 128, EN_OWN = EN_MASK & 256;
#ifndef MK_DUP
#define MK_DUP 0
#endif
constexpr int NPH = 22;
#ifndef MK_COOP
#define MK_COOP 1
#endif
constexpr size_t MiB = 1u << 20;
constexpr size_t WS_CNT = 0;
constexpr size_t WS_BAR = 16 * 1024;
constexpr size_t WS_KMEAN = 64 * 1024;
constexpr size_t WS_SSQ = 1 * MiB;
constexpr size_t WS_ROPE = 4 * MiB;
constexpr size_t WS_MEMB = 12 * MiB;
constexpr size_t WS_MKV = 14 * MiB;
constexpr size_t WS_ML = 18 * MiB;
constexpr size_t WS_WT = 22 * MiB;
constexpr size_t WT_LAYER = 160 * MiB, WT_GU1 = 0, WT_D1 = 44 * MiB, WT_IN = 66 * MiB, WT_OUT = 86 * MiB, WT_GU2 = 94 * MiB, WT_D2 = 138 * MiB;
constexpr size_t WS_XB = 350 * MiB;
constexpr size_t WS_LIST = WS_XB, WS_VT = WS_XB + 32 * MiB;
constexpr size_t WS_H = 414 * MiB;
constexpr size_t WS_MIX = 590 * MiB;
constexpr size_t WS_PART = 654 * MiB;
constexpr size_t WS_END = 750 * MiB;
constexpr int LDS_BYTES = 147456;
constexpr int KS_STRIDE = 272, VT_STRIDE = 528, LDS_KS = 0, LDS_VT = 256 * KS_STRIDE, LDS_MISC = 139264;
static_assert(LDS_VT + 128 * VT_STRIDE <= LDS_MISC, "lds map");

#define TID_LOCALS int tid_ = threadIdx.x; asm volatile("" : "+v"(tid_)); const int tid = tid_, lane = tid & 63, wave = __builtin_amdgcn_readfirstlane(tid >> 6), r32 = lane & 31, hi = lane >> 5; (void)r32; (void)hi; (void)wave; (void)lane;
struct Args { const void* in[19]; float* out; unsigned char* ws; float inv_freq[64]; int ph_lo, ph_hi; };

__device__ __forceinline__ unsigned cvtpk(float lo, float hi) { f32x2 v = {lo, hi}; bf16x2_t b = __builtin_convertvector(v, bf16x2_t); return __builtin_bit_cast(unsigned, b); }
__device__ __forceinline__ float bflo(unsigned w) { return __uint_as_float(w << 16); }
__device__ __forceinline__ float bfhi(unsigned w) { return __uint_as_float(w & 0xffff0000u); }
__device__ __forceinline__ float wave_sum(float v) {
#pragma unroll
    for (int o = 1; o < 64; o <<= 1) v += __shfl_xor(v, o);
    return v;
}
__device__ __forceinline__ int crow(int r, int hi) { return (r & 3) + 8 * (r >> 2) + 4 * hi; }
#define MFMA32(a, b, c) __builtin_amdgcn_mfma_f32_32x32x16_bf16((a), (b), (c), 0, 0, 0)

__device__ __forceinline__ void tr_item(const float* W, int K, int N, bf16_t* WT, const float* gain, int perm, LAS float* scr, int item, int lane) {
    const int nblk = N / 64, kb = item / nblk, nb = item % nblk, k0 = 64 * kb, n0 = 64 * nb, lr = lane >> 4, c4 = lane & 15;
    f32x4 v[16];
#pragma unroll
    for (int i = 0; i < 16; ++i) v[i] = *(const f32x4*)(W + (size_t)(k0 + lr + 4 * i) * N + n0 + 4 * c4);
    if (gain) {
#pragma unroll
        for (int i = 0; i < 16; ++i) v[i] = v[i] * gain[k0 + lr + 4 * i];
    }
#pragma unroll
    for (int i = 0; i < 16; ++i)
#pragma unroll
        for (int e = 0; e < 4; ++e) scr[(lr + 4 * i) * 65 + 4 * c4 + e] = v[i][e];
    asm volatile("s_waitcnt lgkmcnt(0)" ::: "memory");
    const int c = lane & 7;
#pragma unroll
    for (int j = 0; j < 8; ++j) { const int n = (lane >> 3) + 8 * j; const LAS float* s = scr + (8 * c) * 65 + n;
        u32x4 o; o.x = cvtpk(s[0 * 65], s[1 * 65]); o.y = cvtpk(s[2 * 65], s[3 * 65]); o.z = cvtpk(s[4 * 65], s[5 * 65]); o.w = cvtpk(s[6 * 65], s[7 * 65]);
        const int ncol = n0 + n; int drow = ncol;
        if (perm) { const int hf = ncol >= DFF ? 1 : 0, jj = ncol - hf * DFF; drow = 256 * (jj >> 7) + 128 * hf + (jj & 127); }
        *(u32x4*)(WT + (size_t)drow * K + k0 + 8 * c) = o; }
    asm volatile("s_waitcnt lgkmcnt(0)" ::: "memory");
}

template <bool CAUSAL>
__device__ __forceinline__ void attn_tile(const LAS unsigned char* Ks, const LAS unsigned char* Vts, const bf16x8 (&qf)[8], int qi, int r32, int hi, f32x16 (&O)[4], float& m2, float& l) {
    const float c = 0.08838834764831845f * 1.4426950408889634f;
    float m = -1.0e30f, lsum = 0.f;
#pragma unroll
    for (int d = 0; d < 4; ++d)
#pragma unroll
        for (int r = 0; r < 16; ++r) O[d][r] = 0.f;
#pragma unroll 1
    for (int hf = 0; hf < 2; ++hf) {
        f32x16 S[4];
#pragma unroll
        for (int s = 0; s < 4; ++s) {
            f32x16 a;
#pragma unroll
            for (int r = 0; r < 16; ++r) a[r] = 0.f;
            const LAS unsigned char* kp = Ks + (128 * hf + 32 * s + r32) * KS_STRIDE + 16 * hi;
#pragma unroll
            for (int d0 = 0; d0 < 8; ++d0) { const bf16x8 kf = *(const LAS bf16x8*)(kp + 32 * d0); a = MFMA32(kf, qf[d0], a); }
            S[s] = a;
            __builtin_amdgcn_sched_barrier(0);
        }
        float mx = -1.0e30f;
#pragma unroll
        for (int s = 0; s < 4; ++s)
#pragma unroll
            for (int r = 0; r < 16; ++r) { float v = S[s][r]; if (CAUSAL) { if (128 * hf + 32 * s + crow(r, hi) > qi) v = -INFINITY; S[s][r] = v; } mx = fmaxf(mx, v); }
        mx = fmaxf(mx, __shfl_xor(mx, 32));
        const float mn = fmaxf(m, mx * c), alpha = __builtin_amdgcn_exp2f(m - mn);
        m = mn; lsum *= alpha;
#pragma unroll
        for (int d = 0; d < 4; ++d)
#pragma unroll
            for (int r = 0; r < 16; ++r) O[d][r] *= alpha;
#pragma unroll
        for (int s = 0; s < 4; ++s)
#pragma unroll
            for (int r = 0; r < 16; ++r) { const float p = __builtin_amdgcn_exp2f(S[s][r] * c - mn); S[s][r] = p; lsum += p; }
#pragma unroll
        for (int s = 0; s < 4; ++s)
#pragma unroll
            for (int j = 0; j < 2; ++j) {
                u32x4 pw; pw.x = cvtpk(S[s][8 * j + 0], S[s][8 * j + 1]); pw.y = cvtpk(S[s][8 * j + 2], S[s][8 * j + 3]); pw.z = cvtpk(S[s][8 * j + 4], S[s][8 * j + 5]); pw.w = cvtpk(S[s][8 * j + 6], S[s][8 * j + 7]);
                const bf16x8 pf = __builtin_bit_cast(bf16x8, pw);
#pragma unroll
                for (int d = 0; d < 4; ++d) {
                    const LAS unsigned char* vp = Vts + (32 * d + r32) * VT_STRIDE + (128 * hf + 32 * s + 16 * j + 4 * hi) * 2;
                    const s16x4 lo = *(const LAS s16x4*)vp, h4 = *(const LAS s16x4*)(vp + 16);
                    const bf16x8 vf = __builtin_shufflevector(lo, h4, 0, 1, 2, 3, 4, 5, 6, 7);
                    O[d] = MFMA32(vf, pf, O[d]);
                }
                __builtin_amdgcn_sched_barrier(0);
            }
    }
    lsum += __shfl_xor(lsum, 32);
    m2 = m; l = lsum;
}
__device__ __forceinline__ void stage_kv(LAS unsigned char* lds, const bf16_t* Kg, int kpitch, const bf16_t* Vtg, int tid) {
#pragma unroll
    for (int i = 0; i < 8; ++i) { const int c = tid + 512 * i, row = c >> 4, ch = c & 15; *(LAS u32x4*)(lds + LDS_KS + row * KS_STRIDE + ch * 16) = *(const u32x4*)(Kg + (size_t)row * kpitch + ch * 8); }
#pragma unroll
    for (int i = 0; i < 8; ++i) { const int c = tid + 512 * i, row = c >> 5, ch = c & 31; *(LAS u32x4*)(lds + LDS_VT + row * VT_STRIDE + ch * 16) = *(const u32x4*)(Vtg + (size_t)row * 256 + ch * 8); }
}
__device__ __forceinline__ void store_orow(bf16_t* orow, const f32x16 (&O)[4], float sc, int hi, bool st) {
#pragma unroll
    for (int d = 0; d < 4; ++d)
#pragma unroll
        for (int k = 0; k < 2; ++k) {
            const unsigned x0 = cvtpk(O[d][8 * k + 0] * sc, O[d][8 * k + 1] * sc), x1 = cvtpk(O[d][8 * k + 2] * sc, O[d][8 * k + 3] * sc);
            const unsigned y0 = cvtpk(O[d][8 * k + 4] * sc, O[d][8 * k + 5] * sc), y1 = cvtpk(O[d][8 * k + 6] * sc, O[d][8 * k + 7] * sc);
            const auto r0 = __builtin_amdgcn_permlane32_swap(x0, y0, false, false), r1 = __builtin_amdgcn_permlane32_swap(x1, y1, false, false);
            u32x4 w; w.x = r0[0]; w.y = r1[0]; w.z = r0[1]; w.w = r1[1];
            if (st) *(u32x4*)(orow + 32 * d + 16 * k + 8 * hi) = w;
        }
}
__device__ __forceinline__ void addmul_prow(f32x16 (&O)[4], const bf16_t* pr, float wt, int hi) {
#pragma unroll
    for (int d = 0; d < 4; ++d)
#pragma unroll
        for (int k = 0; k < 2; ++k) {
            const u32x4 w = *(const u32x4*)(pr + 32 * d + 16 * k + 8 * hi);
            const auto r0 = __builtin_amdgcn_permlane32_swap(w.x, w.z, false, false), r1 = __builtin_amdgcn_permlane32_swap(w.y, w.w, false, false);
            O[d][8 * k + 0] += wt * bflo(r0[0]); O[d][8 * k + 1] += wt * bfhi(r0[0]); O[d][8 * k + 2] += wt * bflo(r1[0]); O[d][8 * k + 3] += wt * bfhi(r1[0]);
            O[d][8 * k + 4] += wt * bflo(r0[1]); O[d][8 * k + 5] += wt * bfhi(r0[1]); O[d][8 * k + 6] += wt * bflo(r1[1]); O[d][8 * k + 7] += wt * bfhi(r1[1]);
        }
}

__device__ __forceinline__ void norm_rope_block(const u32x4 (&a)[4], const u32x4 (&c)[4]  , bf16_t* obase, int opitch, const float* gain, const int* positions, const f32x2* rope, int tok0, bool do_mean, float* kmean, LAS unsigned char* lds, int tid) {
    const int row = tid >> 1, hf = tid & 1, tok = tok0 + row, lane = tid & 63, wave = tid >> 6;
    float x1[32], x2[32]; float ss = 0.f;
#pragma unroll
    for (int i = 0; i < 4; ++i)
#pragma unroll
        for (int e = 0; e < 4; ++e) { x1[8 * i + 2 * e] = bflo(a[i][e]); x1[8 * i + 2 * e + 1] = bfhi(a[i][e]); x2[8 * i + 2 * e] = bflo(c[i][e]); x2[8 * i + 2 * e + 1] = bfhi(c[i][e]); }
#pragma unroll
    for (int i = 0; i < 32; ++i) ss += x1[i] * x1[i] + x2[i] * x2[i];
    ss += __shfl_xor(ss, 1);
    const float rstd = 1.0f / sqrtf(ss * (1.0f / 128.0f) + 1e-6f);
    const f32x2* rt = rope + (size_t)tok * 64 + 32 * hf;
#pragma unroll
    for (int i = 0; i < 32; ++i) { const float n1 = x1[i] * rstd * gain[32 * hf + i], n2 = x2[i] * rstd * gain[64 + 32 * hf + i]; const f32x2 cs = rt[i];
        x1[i] = n1 * cs.x - n2 * cs.y; x2[i] = n2 * cs.x + n1 * cs.y; }
#pragma unroll
    for (int i = 0; i < 4; ++i) { u32x4 w, v;
#pragma unroll
        for (int e = 0; e < 4; ++e) { w[e] = cvtpk(x1[8 * i + 2 * e], x1[8 * i + 2 * e + 1]); v[e] = cvtpk(x2[8 * i + 2 * e], x2[8 * i + 2 * e + 1]); }
        bf16_t* po = obase + (size_t)row * opitch; *(u32x4*)(po + 32 * hf + 8 * i) = w; *(u32x4*)(po + 64 + 32 * hf + 8 * i) = v; }
    if (do_mean) {
        LAS float* tile = (LAS float*)lds;
#pragma unroll
        for (int i = 0; i < 8; ++i) { *(LAS f32x4*)(tile + row * 132 + 32 * hf + 4 * i) = (f32x4){x1[4 * i], x1[4 * i + 1], x1[4 * i + 2], x1[4 * i + 3]};
                                      *(LAS f32x4*)(tile + row * 132 + 64 + 32 * hf + 4 * i) = (f32x4){x2[4 * i], x2[4 * i + 1], x2[4 * i + 2], x2[4 * i + 3]}; }
        __syncthreads();
        { const int d = tid & 127, q4 = tid >> 7; float sacc = 0.f;
#pragma unroll 16
          for (int r = 0; r < 64; ++r) sacc += tile[(64 * q4 + r) * 132 + d];
          LAS float* part = (LAS float*)(lds + LDS_MISC);
          part[q4 * 128 + d] = sacc; }
        __syncthreads();
        if (tid < 128) { LAS float* part = (LAS float*)(lds + LDS_MISC); kmean[tid] = ((part[tid] + part[128 + tid]) + (part[256 + tid] + part[384 + tid])) * (1.0f / 256.0f); }
        __syncthreads();
    }
}

#define XB_TMO      128
#define XB_XCNT(j)  (256  + 64 * (j))
#define XB_XSUB(j)  (1280 + 64 * (j))
#define XB_XGEN(j)  (2304 + 64 * (j))
#define XB_TOP      3328
#define XB_TOPGEN   3392
#define XCD_BAR_WORDS 3456
#define XB_SPIN_CAP (1u << 18)

__device__ __forceinline__ unsigned xb_ld(unsigned* p)              { return __hip_atomic_load(p, __ATOMIC_RELAXED, __HIP_MEMORY_SCOPE_AGENT); }
__device__ __forceinline__ unsigned xb_add(unsigned* p, unsigned v) { return __hip_atomic_fetch_add(p, v, __ATOMIC_RELAXED, __HIP_MEMORY_SCOPE_AGENT); }
__device__ __forceinline__ unsigned xb_xcc_id() { return (unsigned)__builtin_amdgcn_s_getreg((3 << 11) | 20) & 0xFu; }
#define XB_SPIN(cond, bar) do { unsigned _sp = 0; while (cond) { __builtin_amdgcn_s_sleep(1); \
    if ((++_sp & 255u) == 0u) { if (xb_ld(&(bar)[XB_TMO])) break; if (_sp > XB_SPIN_CAP) { atomicAdd(&(bar)[XB_TMO], 1u); break; } } } } while (0)

struct XcdBarrier {
    unsigned* bar; unsigned x;
    volatile LAS unsigned* st;
};

__device__ __forceinline__ XcdBarrier xcd_barrier_post(unsigned* bar, volatile LAS unsigned* st) {
    XcdBarrier b; b.bar = bar; b.x = xb_xcc_id(); b.st = st;
    if (threadIdx.x == 0) (void)xb_add(&bar[XB_XCNT(b.x)], 1u);
    return b;
}
__device__ __forceinline__ void xcd_barrier_complete(unsigned* bar, unsigned x, unsigned& nloc, unsigned& nx) {
    const unsigned G = gridDim.x * gridDim.y * gridDim.z;
    unsigned sum, cnt, mine, sp = 0u;
    for (;;) {
        sum = 0u; cnt = 0u; mine = 0u;
#pragma unroll
        for (unsigned j = 0; j < 16; ++j) { const unsigned c = xb_ld(&bar[XB_XCNT(j)]); sum += c; cnt += (c > 0u) ? 1u : 0u; mine = (j == x) ? c : mine; }
        if (sum == G) break;
        __builtin_amdgcn_s_sleep(1);
        if ((++sp & 255u) == 0u) { if (xb_ld(&bar[XB_TMO])) break; if (sp > XB_SPIN_CAP) { atomicAdd(&bar[XB_TMO], 1u); break; } }
    }
    nloc = mine > 0u ? mine : 1u; nx = cnt > 0u ? cnt : 1u;
}

__device__ __forceinline__ void xcd_barrier(const XcdBarrier& b) {
    asm volatile("s_waitcnt vmcnt(0)" ::: "memory");
    __syncthreads();
    if (threadIdx.x == 0) {
        unsigned* bar = b.bar;
        __builtin_amdgcn_s_waitcnt(0);
        unsigned nloc = b.st[0], nx = b.st[1];
        if (nloc == 0u) { xcd_barrier_complete(bar, b.x, nloc, nx); b.st[0] = nloc; b.st[1] = nx; }
        const unsigned old = xb_add(&bar[XB_XSUB(b.x)], 1u);
        const unsigned gen = old / nloc;
        if (old + 1u == (gen + 1u) * nloc) {
            __builtin_amdgcn_fence(__ATOMIC_RELEASE, "agent");
            asm volatile("s_waitcnt vmcnt(0)" ::: "memory");
            const unsigned og = xb_add(&bar[XB_TOP], 1u);
            const unsigned tg = og / nx;
            if (og + 1u == (tg + 1u) * nx) xb_add(&bar[XB_TOPGEN], 1u);
            else XB_SPIN(xb_ld(&bar[XB_TOPGEN]) == tg, bar);
            __builtin_amdgcn_fence(__ATOMIC_ACQUIRE, "agent");
            xb_add(&bar[XB_XGEN(b.x)], 1u);
            asm volatile("s_waitcnt vmcnt(0)" ::: "memory");
        } else {
            XB_SPIN(xb_ld(&bar[XB_XGEN(b.x)]) == gen, bar);
            __builtin_amdgcn_fence(__ATOMIC_ACQUIRE, "agent");
            asm volatile("s_waitcnt vmcnt(0)" ::: "memory");
        }
    }
    __syncthreads();
}

__global__ void __launch_bounds__(512, 2) mk_fwd(Args a) {
    extern __shared__ __attribute__((aligned(16))) unsigned char lds_raw[];
    LAS unsigned char* lds = (LAS unsigned char*)lds_raw;
    cg::grid_group grid = cg::this_grid();
    volatile LAS unsigned* bst = (volatile LAS unsigned*)(lds + LDS_BYTES - 16);
    if (threadIdx.x < 2) bst[threadIdx.x] = 0u;
    __syncthreads();
    XcdBarrier bar; bar.bar = nullptr; bar.x = 0; bar.st = bst;
    int redo_ = 0;
    for (int ph = a.ph_lo; ph < a.ph_hi; ++ph) {
        int bid_ = blockIdx.x, G_ = gridDim.x; asm volatile("" : "+s"(bid_), "+s"(G_));
        const int G = G_, bid = bid_;
        unsigned char* ws = a.ws; asm volatile("" : "+s"(ws));
        const float* x_in = (const float*)a.in[0]; const float* mem = (const float*)a.in[1]; const int* positions = (const int*)a.in[2];
        float* X = a.out;
        unsigned* CNT = (unsigned*)(ws + WS_CNT); float* KMEAN = (float*)(ws + WS_KMEAN); float* SSQ = (float*)(ws + WS_SSQ); f32x2* ROPE = (f32x2*)(ws + WS_ROPE);
        bf16_t* MEMB = (bf16_t*)(ws + WS_MEMB); float* MKV = (float*)(ws + WS_MKV); f32x2* ML = (f32x2*)(ws + WS_ML);
        bf16_t* XB = (bf16_t*)(ws + WS_XB); unsigned* LIST = (unsigned*)a.out; bf16_t* VT = (bf16_t*)((unsigned char*)a.out + 32 * MiB);
        bf16_t* H = (bf16_t*)(ws + WS_H); bf16_t* PROJ = (bf16_t*)(ws + WS_H); bf16_t* MIX = (bf16_t*)(ws + WS_MIX); bf16_t* PART = (bf16_t*)(ws + WS_PART);
        bf16_t* WT_MKV = (bf16_t*)(ws + WS_WT);

        const int s_ = ph >= 2 ? (ph - 2) % 10 : -1;
        const int nrep = (((MK_DUP & 1) && ph == 0) || ((MK_DUP & 2) && (s_ == 5 || s_ == 6)) || ((MK_DUP & 4) && (s_ == 0 || s_ == 8)) || ((MK_DUP & 8) && s_ == 2) || ((MK_DUP & 16) && ph == 1) || ((MK_DUP & 32) && ph == 3) || ((MK_DUP & 64) && (s_ == 1 || s_ == 7 || s_ == 9)) || ((MK_DUP & 128) && s_ == 3)) ? 2 : 1;
        for (int rep = 0; rep < nrep; ++rep) {
        if (rep) __syncthreads();
        if (EN_P0 && ph == 0) {
            TID_LOCALS
            LAS float* scr = (LAS float*)(lds + wave * 16640);
            const int gw = bid * 8 + wave, NGW = G * 8;
            constexpr int I_MKV = 32 * 16;
            for (int it = gw; it < 2 * I_MKV; it += NGW) { const int l = it >= I_MKV ? 1 : 0, r = it - l * I_MKV;
                tr_item((const float*)a.in[12] + (size_t)l * DM * 1024, DM, 1024, WT_MKV + (size_t)l * 1024 * DM, nullptr, 0, scr, r, lane); }
            for (int mr = gw; mr < 512; mr += NGW) {
                const int ml = mr >> 8;
                const f32x4* xr = (const f32x4*)(mem + (size_t)(mr & 255) * DM) + lane;
                f32x4 v[8]; float ss = 0.f;
#pragma unroll
                for (int j = 0; j < 8; ++j) { v[j] = xr[64 * j]; ss += (v[j][0] * v[j][0] + v[j][1] * v[j][1]) + (v[j][2] * v[j][2] + v[j][3] * v[j][3]); }
                ss = wave_sum(ss);
                const float rstd = 1.0f / sqrtf(ss * (1.0f / DM) + 1e-6f); const f32x4* gn = (const f32x4*)((const float*)a.in[11] + ml * DM) + lane;
                u32x2* o = (u32x2*)(MEMB + (size_t)mr * DM) + lane;
#pragma unroll
                for (int j = 0; j < 8; ++j) { const f32x4 g = gn[64 * j]; o[64 * j] = (u32x2){cvtpk(v[j][0] * rstd * g[0], v[j][1] * rstd * g[1]), cvtpk(v[j][2] * rstd * g[2], v[j][3] * rstd * g[3])}; }
            }
            if (bid == 0) { CNT[tid] = 0u; CNT[512 + tid] = 0u; CNT[1024 + tid] = 0u; unsigned* bw = (unsigned*)(ws + WS_BAR); for (int i = tid; i < XCD_BAR_WORDS; i += 512) bw[i] = 0u; }
        } else if (EN_P1 && ph == 1 && bid < 8) {
            pg8::Gemm g{MEMB, WT_MKV, 512, 2048, DM}; pg8::MkvOrder S{bid}; pg8::EpiF32 E{MKV, 2048};
            pg8::gemm_phase<pg8::EpiF32, pg8::MkvOrder, true, true>(lds, g, S, E);
        } else if (EN_P0 && ph == 1) {
            TID_LOCALS
            LAS float* scr = (LAS float*)(lds + wave * 16640);
            const int gw = (bid - 8) * 8 + wave, NGW = (G - 8) * 8;
            constexpr int I_GU = 32 * 176, I_D = 88 * 32, I_IN = 32 * 80, I_OUT = 32 * 32, I_LAYER = 2 * I_GU + 2 * I_D + I_IN + I_OUT;
            for (int it = gw; it < 2 * I_LAYER; it += NGW) {
                const int l = it >= I_LAYER ? 1 : 0; int r = it - l * I_LAYER;
                bf16_t* wl = (bf16_t*)(ws + WS_WT + 8 * MiB + (size_t)l * WT_LAYER);
                if (r < I_GU) { tr_item((const float*)a.in[4] + (size_t)l * DM * 2 * DFF, DM, 2 * DFF, (bf16_t*)((unsigned char*)wl + WT_GU1), (const float*)a.in[3] + l * DM, 1, scr, r, lane); continue; } r -= I_GU;
                if (r < I_GU) { tr_item((const float*)a.in[17] + (size_t)l * DM * 2 * DFF, DM, 2 * DFF, (bf16_t*)((unsigned char*)wl + WT_GU2), (const float*)a.in[16] + l * DM, 1, scr, r, lane); continue; } r -= I_GU;
                if (r < I_D) { tr_item((const float*)a.in[5] + (size_t)l * DFF * DM, DFF, DM, (bf16_t*)((unsigned char*)wl + WT_D1), nullptr, 0, scr, r, lane); continue; } r -= I_D;
                if (r < I_D) { tr_item((const float*)a.in[18] + (size_t)l * DFF * DM, DFF, DM, (bf16_t*)((unsigned char*)wl + WT_D2), nullptr, 0, scr, r, lane); continue; } r -= I_D;
                if (r < I_IN) { tr_item((const float*)a.in[7] + (size_t)l * DM * INW, DM, INW, (bf16_t*)((unsigned char*)wl + WT_IN), (const float*)a.in[6] + l * DM, 0, scr, r, lane); continue; } r -= I_IN;
                tr_item((const float*)a.in[15] + (size_t)l * DM * DM, DM, DM, (bf16_t*)((unsigned char*)wl + WT_OUT), nullptr, 0, scr, r, lane);
            }
            for (int i = (bid - 8) * 512 + tid; i < SEQ * 64; i += (G - 8) * 512) {
                const int t = i >> 6, fi = i & 63; const float ang = (float)positions[t] * a.inv_freq[fi];
                double rev = (double)ang * 0.15915494309189535; rev -= __builtin_rint(rev); const float fr = (float)rev;
                ROPE[i] = (f32x2){__builtin_amdgcn_cosf(fr), __builtin_amdgcn_sinf(fr)};
            }
            for (int row = gw; row < SEQ; row += NGW) {
                const f32x4* xr = (const f32x4*)(x_in + (size_t)row * DM) + lane;
                f32x4 v[8]; float ss = 0.f;
#pragma unroll
                for (int j = 0; j < 8; ++j) { v[j] = xr[64 * j]; ss += (v[j][0] * v[j][0] + v[j][1] * v[j][1]) + (v[j][2] * v[j][2] + v[j][3] * v[j][3]); }
                ss = wave_sum(ss);
                u32x2* o = (u32x2*)(XB + (size_t)row * DM) + lane;
#pragma unroll
                for (int j = 0; j < 8; ++j) o[64 * j] = (u32x2){cvtpk(v[j][0], v[j][1]), cvtpk(v[j][2], v[j][3])};
                if (lane < 32) SSQ[(size_t)row * 32 + lane] = lane == 0 ? ss : 0.f;
            }
        } else {
            const int l = (ph - 2) / 10, s = (ph - 2) % 10;
            unsigned char* wl = ws + WS_WT + 8 * MiB + (size_t)l * WT_LAYER;
            if (EN_GU && (s == 0 || s == 8)) {
                pg8::Gemm g{XB, (const bf16_t*)(wl + (s == 0 ? WT_GU1 : WT_GU2)), SEQ, 2 * DFF, DM}; pg8::StaticOrder S; S.init(SEQ, 2 * DFF, G, bid);
                pg8::EpiSwiglu E{H, SSQ, {{0.f, 0.f, 0.f, 0.f}, {0.f, 0.f, 0.f, 0.f}}, -1};
                pg8::gemm_phase<pg8::EpiSwiglu, pg8::StaticOrder, true, true>(lds, g, S, E);
            } else if (EN_RES && (s == 1 || s == 7 || s == 9)) {
                const bool isout = (s == 7);
                pg8::Gemm g{isout ? MIX : H, (const bf16_t*)(wl + (s == 1 ? WT_D1 : (isout ? WT_OUT : WT_D2))), SEQ, DM, isout ? DM : DFF}; pg8::StaticOrder S; S.init(SEQ, DM, G, bid);
                pg8::EpiResid E{(l == 0 && s == 1) ? x_in : nullptr, (ph == NPH - 1) ? X : nullptr, XB, SSQ, ((MK_DUP & 64) && rep == 0) ? 0.0f : (isout ? 1.0f : 0.5f)};
                pg8::gemm_phase<pg8::EpiResid, pg8::StaticOrder, true, true>(lds, g, S, E);
            } else if (EN_PROJ && s == 2) {
                pg8::Gemm g{XB, (const bf16_t*)(wl + WT_IN), SEQ, INW, DM}; pg8::StaticOrder S; S.init(SEQ, INW, G, bid);
                pg8::EpiProj E{PROJ, INW, SSQ, {{0.f, 0.f, 0.f, 0.f}, {0.f, 0.f, 0.f, 0.f}}, -1};
                pg8::gemm_phase<pg8::EpiProj, pg8::StaticOrder, true, true>(lds, g, S, E);
            } else if (EN_PRE && s == 3) {
                for (int it = bid; it < 1024; it += G) {
                    const int w = it & 255, kk = it >> 8, b = w & 63, sl = (w >> 6) + 4 * kk, tok0 = 256 * b;
                    if (sl < 8) {
                        TID_LOCALS
                        const int h = sl;
                        u32x4 qa[4], qc[4], ka[4], kc[4];
                        { const bf16_t* pq = PROJ + (size_t)(tok0 + (tid >> 1)) * INW + 128 * h + 32 * (tid & 1); const bf16_t* pk = pq + 1024;
#pragma unroll
                          for (int i = 0; i < 4; ++i) { qa[i] = *(const u32x4*)(pq + 8 * i); qc[i] = *(const u32x4*)(pq + 64 + 8 * i); ka[i] = *(const u32x4*)(pk + 8 * i); kc[i] = *(const u32x4*)(pk + 64 + 8 * i); } }
                        const int dch = tid & 15, tg = tid >> 4;
                        const bf16_t* vsrc = PROJ + (size_t)(tok0 + 8 * tg) * INW + 2048 + 128 * h + 8 * dch;
                        u32x4 rw[8];
#pragma unroll
                        for (int e = 0; e < 8; ++e) rw[e] = *(const u32x4*)(vsrc + (size_t)e * INW);
                        {
                        const bool dummy_ = (MK_DUP & 128) && rep == 0; bf16_t* ob_ = dummy_ ? MIX + (size_t)tok0 * DM + 128 * h : nullptr;
                        norm_rope_block(qa, qc, dummy_ ? ob_ : PROJ + (size_t)tok0 * INW + 128 * h, dummy_ ? DM : INW, (const float*)a.in[8] + l * HD, positions, ROPE, tok0, false, nullptr, lds, tid);
                        norm_rope_block(ka, kc, dummy_ ? ob_ : PROJ + (size_t)tok0 * INW + 1024 + 128 * h, dummy_ ? DM : INW, (const float*)a.in[9] + l * HD, positions, ROPE, tok0, true, KMEAN + (size_t)(h * 64 + b) * 128, lds, tid);
                        }
                        bf16_t* vdst = VT + ((size_t)(h * 64 + b) * 128 + 8 * dch) * 256 + 8 * tg;
#pragma unroll
                        for (int c = 0; c < 8; ++c) { u32x4 o;
#pragma unroll
                            for (int e2 = 0; e2 < 4; ++e2) { const unsigned lo = rw[2 * e2][c >> 1], hh = rw[2 * e2 + 1][c >> 1];
                                o[e2] = (c & 1) ? ((lo >> 16) | (hh & 0xffff0000u)) : ((lo & 0xffffu) | (hh << 16)); }
                            *(u32x4*)(vdst + (size_t)c * 256) = o; }
                    } else if (sl < 12) {
                        TID_LOCALS
                        const int g = sl - 8, ch = tid & 15, tl = tid >> 4, c0 = 128 * g + 8 * ch, t0 = tok0 + 8 * tl;
                        const float* cw = (const float*)a.in[10] + l * 3 * 512 + c0;
                        float w0[8], w1[8], w2[8];
#pragma unroll
                        for (int e = 0; e < 8; ++e) { w0[e] = cw[e]; w1[e] = cw[512 + e]; w2[e] = cw[1024 + e]; }
                        float um2[8], um1[8];
#pragma unroll
                        for (int e = 0; e < 8; ++e) { um2[e] = 0.f; um1[e] = 0.f; }
                        if (t0 >= 2) {
                            const u32x4 c2 = *(const u32x4*)(PROJ + (size_t)(t0 - 2) * INW + 3584 + c0), x2 = *(const u32x4*)(PROJ + (size_t)(t0 - 2) * INW + 4096 + c0);
                            const u32x4 c1 = *(const u32x4*)(PROJ + (size_t)(t0 - 1) * INW + 3584 + c0), x1 = *(const u32x4*)(PROJ + (size_t)(t0 - 1) * INW + 4096 + c0);
#pragma unroll
                            for (int e = 0; e < 4; ++e) { um2[2 * e] = bflo(c2[e]) * bflo(x2[e]); um2[2 * e + 1] = bfhi(c2[e]) * bfhi(x2[e]); um1[2 * e] = bflo(c1[e]) * bflo(x1[e]); um1[2 * e + 1] = bfhi(c1[e]) * bfhi(x1[e]); }
                        }
#pragma unroll
                        for (int k = 0; k < 8; ++k) { const size_t ro = (size_t)(t0 + k) * INW;
                            const u32x4 cb = *(const u32x4*)(PROJ + ro + 3072 + c0), cc = *(const u32x4*)(PROJ + ro + 3584 + c0), cx = *(const u32x4*)(PROJ + ro + 4096 + c0);
                            float uc[8], y[8];
#pragma unroll
                            for (int e = 0; e < 4; ++e) { uc[2 * e] = bflo(cc[e]) * bflo(cx[e]); uc[2 * e + 1] = bfhi(cc[e]) * bfhi(cx[e]); }
#pragma unroll
                            for (int e = 0; e < 8; ++e) y[e] = w0[e] * um2[e] + w1[e] * um1[e] + w2[e] * uc[e];
                            u32x4 o;
#pragma unroll
                            for (int e = 0; e < 4; ++e) o[e] = cvtpk(y[2 * e] * bflo(cb[e]), y[2 * e + 1] * bfhi(cb[e]));
                            *(u32x4*)(MIX + (size_t)(t0 + k) * DM + 1024 + c0) = o;
#pragma unroll
                            for (int e = 0; e < 8; ++e) { um2[e] = um1[e]; um1[e] = uc[e]; } }
                    } else {
                        TID_LOCALS
                        const int hm = sl - 12;
                        { const int m = tid >> 1, hf = tid & 1;
                          const f32x4* kr = (const f32x4*)(MKV + (size_t)(256 * l + m) * 2048 + 1024 * l + 128 * hm + 64 * hf);
                          const f32x4* gk = (const f32x4*)((const float*)a.in[14] + l * HD + 64 * hf);
                          f32x4 v[16]; float ss = 0.f;
#pragma unroll
                          for (int i = 0; i < 16; ++i) { v[i] = kr[i]; ss += (v[i][0] * v[i][0] + v[i][1] * v[i][1]) + (v[i][2] * v[i][2] + v[i][3] * v[i][3]); }
                          ss += __shfl_xor(ss, 1);
                          const float rstd = 1.0f / sqrtf(ss * (1.0f / 128.0f) + 1e-6f);
#pragma unroll
                          for (int i = 0; i < 8; ++i) { const f32x4 g0 = gk[2 * i], g1 = gk[2 * i + 1]; const f32x4 p0 = v[2 * i] * rstd * g0, p1 = v[2 * i + 1] * rstd * g1;
                              u32x4 o; o.x = cvtpk(p0[0], p0[1]); o.y = cvtpk(p0[2], p0[3]); o.z = cvtpk(p1[0], p1[1]); o.w = cvtpk(p1[2], p1[3]);
                              *(LAS u32x4*)(lds + LDS_KS + m * KS_STRIDE + 128 * hf + 16 * i) = o; }
                          const f32x4* vr = kr + 128;
#pragma unroll
                          for (int i = 0; i < 16; ++i) { const f32x4 vv = vr[i];
#pragma unroll
                              for (int e = 0; e < 4; ++e) *(LAS bf16_t*)(lds + LDS_VT + (64 * hf + 4 * i + e) * VT_STRIDE + 2 * m) = (bf16_t)(cvtpk(vv[e], 0.f) & 0xffffu); }
                        }
                        __syncthreads();
                        const int tok = tok0 + 32 * wave + r32;
                        const bf16_t* qrow = PROJ + (size_t)tok * INW + 4608 + 128 * hm + 8 * hi;
                        const float* gq = (const float*)a.in[13] + l * HD + 8 * hi;
                        u32x4 qr[8]; float ss = 0.f;
#pragma unroll
                        for (int d0 = 0; d0 < 8; ++d0) { qr[d0] = *(const u32x4*)(qrow + 16 * d0);
#pragma unroll
                            for (int e = 0; e < 4; ++e) { const float lo = bflo(qr[d0][e]), hh = bfhi(qr[d0][e]); ss += lo * lo + hh * hh; } }
                        ss += __shfl_xor(ss, 32);
                        const float rstd = 1.0f / sqrtf(ss * (1.0f / 128.0f) + 1e-6f);
                        bf16x8 qf[8];
#pragma unroll
                        for (int d0 = 0; d0 < 8; ++d0) { u32x4 o;
#pragma unroll
                            for (int e = 0; e < 4; ++e) o[e] = cvtpk(bflo(qr[d0][e]) * rstd * gq[16 * d0 + 2 * e], bfhi(qr[d0][e]) * rstd * gq[16 * d0 + 2 * e + 1]);
                            qf[d0] = __builtin_bit_cast(bf16x8, o); }
                        f32x16 O[4]; float m2, ll;
                        attn_tile<false>(lds + LDS_KS, lds + LDS_VT, qf, 0, r32, hi, O, m2, ll);
                        store_orow(MIX + (size_t)tok * DM + 1536 + 128 * hm, O, 1.0f / ll, hi, true);
                        __syncthreads();
                    }
                }
            } else if (EN_GATE && s == 4) {
                for (int it = bid; it < 512; it += G) {
                    TID_LOCALS
                    const int h = it & 7, qc = it >> 3;
                    if (qc == 0) continue;
                    { const int j = tid >> 3, dc = (tid & 7) * 16; const f32x4* src = (const f32x4*)(KMEAN + ((size_t)h * 64 + j) * 128 + dc);
                      u32x4 hw[2], lw[2];
#pragma unroll
                      for (int i = 0; i < 4; ++i) { const f32x4 v = src[i]; float r_[4];
#pragma unroll
                          for (int e = 0; e < 4; ++e) { const unsigned hb = cvtpk(v[e], 0.f) & 0xffffu; r_[e] = v[e] - __uint_as_float(hb << 16); }
                          hw[i >> 1][2 * (i & 1)] = cvtpk(v[0], v[1]); hw[i >> 1][2 * (i & 1) + 1] = cvtpk(v[2], v[3]);
                          lw[i >> 1][2 * (i & 1)] = cvtpk(r_[0], r_[1]); lw[i >> 1][2 * (i & 1) + 1] = cvtpk(r_[2], r_[3]); }
                      *(LAS u32x4*)(lds + j * KS_STRIDE + dc * 2) = hw[0]; *(LAS u32x4*)(lds + j * KS_STRIDE + dc * 2 + 16) = hw[1];
                      *(LAS u32x4*)(lds + 64 * KS_STRIDE + j * KS_STRIDE + dc * 2) = lw[0]; *(LAS u32x4*)(lds + 64 * KS_STRIDE + j * KS_STRIDE + dc * 2 + 16) = lw[1]; }
                    __syncthreads();
                    const int tok = 256 * qc + 32 * wave + r32;
                    const bf16_t* qrow = PROJ + (size_t)tok * INW + 128 * h + 8 * hi;
                    bf16x8 qf[8];
#pragma unroll
                    for (int d0 = 0; d0 < 8; ++d0) qf[d0] = *(const bf16x8*)(qrow + 16 * d0);
                    float b0 = -INFINITY, b1 = -INFINITY, b2 = -INFINITY; int i0 = 0, i1 = 0, i2 = 0;
#pragma unroll
                    for (int jt = 0; jt < 2; ++jt) {
                        if (jt == 0 || qc > 32) {
                            f32x16 g;
#pragma unroll
                            for (int r = 0; r < 16; ++r) g[r] = 0.f;
                            const LAS unsigned char* kp = lds + (32 * jt + r32) * KS_STRIDE + 16 * hi;
#pragma unroll
                            for (int d0 = 0; d0 < 8; ++d0) { const bf16x8 kh = *(const LAS bf16x8*)(kp + 32 * d0), kl = *(const LAS bf16x8*)(kp + 64 * KS_STRIDE + 32 * d0);
                                g = MFMA32(kh, qf[d0], g); g = MFMA32(kl, qf[d0], g); }
#pragma unroll
                            for (int r = 0; r < 16; ++r) { const int j = 32 * jt + crow(r, hi); const float v = g[r];
                                if (j < qc) {
                                    if (v > b0) { b2 = b1; i2 = i1; b1 = b0; i1 = i0; b0 = v; i0 = j; }
                                    else if (v > b1) { b2 = b1; i2 = i1; b1 = v; i1 = j; }
                                    else if (v > b2) { b2 = v; i2 = j; } } }
                        }
                    }
                    { const float o0 = __shfl_xor(b0, 32), o1 = __shfl_xor(b1, 32), o2 = __shfl_xor(b2, 32); const int p0 = __shfl_xor(i0, 32), p1 = __shfl_xor(i1, 32), p2 = __shfl_xor(i2, 32);
#define MK_INS(v, j) do { const float v_ = (v); const int j_ = (j); \
                          if (v_ > b0 || (v_ == b0 && j_ < i0)) { b2 = b1; i2 = i1; b1 = b0; i1 = i0; b0 = v_; i0 = j_; } \
                          else if (v_ > b1 || (v_ == b1 && j_ < i1)) { b2 = b1; i2 = i1; b1 = v_; i1 = j_; } \
                          else if (v_ > b2 || (v_ == b2 && j_ < i2)) { b2 = v_; i2 = j_; } } while (0)
                      MK_INS(o0, p0); MK_INS(o1, p1); MK_INS(o2, p2);
#undef MK_INS
                    }
                    LAS unsigned* cntl = (LAS unsigned*)(lds + LDS_MISC); LAS unsigned* basel = cntl + 64;
                    if (tid < 64) cntl[tid] = 0u;
                    __syncthreads();
                    unsigned r0 = 0u, r1 = 0u, r2 = 0u;
                    if (hi == 0) { r0 = atomicAdd((unsigned*)(cntl + i0), 1u); if (qc > 1) r1 = atomicAdd((unsigned*)(cntl + i1), 1u); if (qc > 2) r2 = atomicAdd((unsigned*)(cntl + i2), 1u); }
                    __syncthreads();
                    if (tid < 64) { const unsigned n = cntl[tid]; basel[tid] = n ? atomicAdd(CNT + l * 512 + h * 64 + tid, n) : 0u; }
                    __syncthreads();
                    if (hi == 0) {
                        LIST[(size_t)(h * 64 + i0) * SEQ + basel[i0] + r0] = ((unsigned)tok << 2) | 0u;
                        if (qc > 1) LIST[(size_t)(h * 64 + i1) * SEQ + basel[i1] + r1] = ((unsigned)tok << 2) | 1u;
                        if (qc > 2) LIST[(size_t)(h * 64 + i2) * SEQ + basel[i2] + r2] = ((unsigned)tok << 2) | 2u;
                    }
                    __syncthreads();
                }
            } else if (EN_SEL && s == 5) {
                LAS int* pre = (LAS int*)(lds + LDS_MISC); LAS int* wtot = (LAS int*)(lds + LDS_MISC + 2048);
                { TID_LOCALS
                  const int mycnt = (int)CNT[l * 512 + tid];
                  int v = (mycnt + 255) >> 8;
#pragma unroll
                  for (int o = 1; o < 64; o <<= 1) { const int t = __shfl_up(v, o); if (lane >= o) v += t; }
                  if (lane == 63) wtot[wave] = v;
                  __syncthreads();
                  int add = 0;
#pragma unroll
                  for (int w = 0; w < 8; ++w) add += (w < wave) ? wtot[w] : 0;
                  pre[tid] = v + add;
                  __syncthreads(); }
                const int total = pre[511];
                const int vcu = (G % 8 == 0) ? (bid % 8) * (G / 8) + bid / 8 : bid;
                for (int it = vcu; it < total; it += G) {
                    TID_LOCALS
                    int lo = 0, hh = 511;
                    while (lo < hh) { const int mid = (lo + hh) >> 1; if (pre[mid] > it) hh = mid; else lo = mid + 1; }
                    const int p = lo, chunk = it - (p ? pre[p - 1] : 0), h = p >> 6, b = p & 63;
                    const int pc = (int)CNT[l * 512 + p];
                    stage_kv(lds, PROJ + (size_t)(256 * b) * INW + 1024 + 128 * h, INW, VT + (size_t)(h * 64 + b) * 128 * 256, tid);
                    __syncthreads();
                    const int e = chunk * 256 + 32 * wave + r32; const bool valid = e < pc;
                    const unsigned ent = LIST[(size_t)p * SEQ + (valid ? e : 0)]; const int tok = (int)(ent >> 2), slot = (int)(ent & 3u);
                    const bf16_t* qrow = PROJ + (size_t)tok * INW + 128 * h + 8 * hi;
                    bf16x8 qf[8];
#pragma unroll
                    for (int d0 = 0; d0 < 8; ++d0) qf[d0] = *(const bf16x8*)(qrow + 16 * d0);
                    f32x16 O[4]; float m2, ll;
                    attn_tile<false>(lds + LDS_KS, lds + LDS_VT, qf, 0, r32, hi, O, m2, ll);
                    { const size_t pi = ((size_t)h * SEQ + tok) * 3 + slot;
                      store_orow(PART + pi * 128, O, 1.0f / ll, hi, valid);
                      if (valid && hi == 0) ML[pi] = (f32x2){m2, ll}; }
                    __syncthreads();
                }
            } else if (EN_OWN && s == 6) {
                for (int it = bid; it < 512; it += G) {
                    TID_LOCALS
                    const int h = it & 7, b = it >> 3;
                    stage_kv(lds, PROJ + (size_t)(256 * b) * INW + 1024 + 128 * h, INW, VT + (size_t)(h * 64 + b) * 128 * 256, tid);
                    __syncthreads();
                    const int qi = 32 * wave + r32, tok = 256 * b + qi;
                    const bf16_t* qrow = PROJ + (size_t)tok * INW + 128 * h + 8 * hi;
                    bf16x8 qf[8];
#pragma unroll
                    for (int d0 = 0; d0 < 8; ++d0) qf[d0] = *(const bf16x8*)(qrow + 16 * d0);
                    f32x16 O[4]; float m2, ll;
                    attn_tile<true>(lds + LDS_KS, lds + LDS_VT, qf, qi, r32, hi, O, m2, ll);
                    const int nsel = b < 3 ? b : 3; const size_t pi = ((size_t)h * SEQ + tok) * 3;
                    float M = m2;
#pragma unroll 1
                    for (int t = 0; t < nsel; ++t) M = fmaxf(M, ML[pi + t].x);
                    const float wo = __builtin_amdgcn_exp2f(m2 - M); float den = ll * wo;
#pragma unroll
                    for (int d = 0; d < 4; ++d)
#pragma unroll
                        for (int r = 0; r < 16; ++r) O[d][r] *= wo;
#pragma unroll 1
                    for (int t = 0; t < nsel; ++t) { const f32x2 ml = ML[pi + t]; const float wt = ml.y * __builtin_amdgcn_exp2f(ml.x - M); den += wt; addmul_prow(O, PART + (pi + t) * 128, wt, hi); }
                    store_orow(MIX + (size_t)tok * DM + 128 * h, O, 1.0f / den, hi, true);
                    __syncthreads();
                }
            }
        }
        }
#if MK_COOP
        if (ph + 1 < a.ph_hi) {
            if (ph == a.ph_lo) { grid.sync(); bar = xcd_barrier_post((unsigned*)(a.ws + WS_BAR), bst); }
            else xcd_barrier(bar);
        }
#endif
        if ((MK_DUP & 256) && s_ == 3 && redo_ == 0) { redo_ = 1; ph -= 2; } else if (s_ == 4) redo_ = 0;
    }
}

extern "C" void kernel_launch(void* const* d_in, const int* in_sizes, int n_in, void* d_out, int out_size, void* d_ws, size_t ws_size, hipStream_t stream) {
    static int grid = 0;
    if (grid == 0) {
        if (n_in != 19 || out_size != SEQ * DM || ws_size < WS_END) { fprintf(stderr, "kernel_launch: unexpected shapes (n_in %d, out %d, ws %zu); nothing launched\n", n_in, out_size, ws_size); grid = -1; return; }
        int dev = 0, cus = 0, per_cu = 0;
        if (hipGetDevice(&dev) != hipSuccess || hipDeviceGetAttribute(&cus, hipDeviceAttributeMultiprocessorCount, dev) != hipSuccess) { grid = -1; return; }
        if (hipFuncSetAttribute((const void*)mk_fwd, hipFuncAttributeMaxDynamicSharedMemorySize, LDS_BYTES) != hipSuccess) { fprintf(stderr, "kernel_launch: hipFuncSetAttribute failed\n"); grid = -1; return; }
        if (hipOccupancyMaxActiveBlocksPerMultiprocessor(&per_cu, (const void*)mk_fwd, 512, LDS_BYTES) != hipSuccess || per_cu < 1) { fprintf(stderr, "kernel_launch: occupancy query gave %d\n", per_cu); per_cu = 1; }
        (void)hipGetLastError();
        grid = cus * per_cu;
        fprintf(stderr, "kernel_launch: grid %d (%d CUs x %d)\n", grid, cus, per_cu);
    }
    if (grid < 0) return;
    Args a{};
    for (int i = 0; i < 19; ++i) a.in[i] = d_in[i];
    a.out = (float*)d_out; a.ws = (unsigned char*)d_ws;
    for (int i = 0; i < 64; ++i) a.inv_freq[i] = (float)pow(10000.0, -(double)(2 * i) / 128.0);
#if MK_COOP
    a.ph_lo = 0; a.ph_hi = NPH;
    void* args[] = {&a};
    const hipError_t e = hipLaunchCooperativeKernel((const void*)mk_fwd, dim3(grid), dim3(512), args, LDS_BYTES, stream);
    if (e != hipSuccess) fprintf(stderr, "kernel_launch: cooperative launch failed: %s (grid %d)\n", hipGetErrorString(e), grid);
#else
    for (int ph = 0; ph < NPH; ++ph) { a.ph_lo = ph; a.ph_hi = ph + 1; hipLaunchKernelGGL(mk_fwd, dim3(grid), dim3(512), LDS_BYTES, stream, a); }
#endif
}
```

```cpp
#include <hip/hip_runtime.h>
#include <hip/hip_cooperative_groups.h>
#include <cstdio>
#include <cstdint>
#include <cmath>
namespace cg = cooperative_groups;
namespace pg8 {
#define PG8_LAS __attribute__((address_space(3)))
typedef unsigned short bf16_t;
typedef short bf16x8 __attribute__((ext_vector_type(8)));
typedef float f32x4 __attribute__((ext_vector_type(4)));
typedef unsigned u32x4 __attribute__((ext_vector_type(4)));
constexpr int BM = 256, BK = 64, HALF = 128, HTB = HALF * BK * 2  , STAGE_BYTES = 8 * HTB, NXCD = 8, WGM = 8;

__host__ __device__ __forceinline__ int lds_byte(int r, int c) { const int st = (r >> 4) * 2 + (c >> 5), rr = r & 15, cc = c & 31, ob = rr * 64 + cc * 2; return st * 1024 + (ob ^ (((ob >> 9) & 1) << 5)); }
__host__ __device__ __forceinline__ void stage_rc(int b, int& R, int& C) { const int st = b / 1024, sb = b % 1024, swz = sb ^ (((sb >> 9) & 1) << 5); R = (st >> 1) * 16 + swz / 64; C = (st & 1) * 32 + (swz % 64) / 2; }
__host__ __device__ __forceinline__ int perm32(int rho) { const int n = rho >> 4, i = rho & 15; return 8 * (i >> 2) + 4 * n + (i & 3); }

struct Unit { int pm, pn; };
struct Gemm { const bf16_t* A; const bf16_t* Bt; int M, N, K; };

struct StaticOrder {
    int nM, nN, nwg, G, c;
    __host__ __device__ void init(int M, int N, int G_, int c_) { nM = M / BM; nN = N / BM; nwg = nM * nN; G = G_; c = c_; }
    __host__ __device__ bool next(int i, Unit& u) const {
        const long L = (long)i * G + c; if (L >= nwg) return false;
        int wgid = (int)L; { const int q = nwg / NXCD, r = nwg % NXCD, xcd = wgid % NXCD, off = wgid / NXCD; wgid = (xcd < r ? xcd * (q + 1) : r * (q + 1) + (xcd - r) * q) + off; }
        const int nig = WGM * nN, gid = wgid / nig, fm = gid * WGM, gsz = (nM - fm) < WGM ? (nM - fm) : WGM;
        u.pm = fm + ((wgid % nig) % gsz); u.pn = (wgid % nig) / gsz; return true;
    }
    __device__ __forceinline__ void a_ready(const Unit&) const {}
    __device__ __forceinline__ void done(const Unit&) const {}
};

__device__ __forceinline__ unsigned cvt_pk_bf16(float lo, float hi) { unsigned r; asm volatile("v_cvt_pk_bf16_f32 %0, %1, %2" : "=v"(r) : "v"(lo), "v"(hi)); return r; }
typedef float f32x2 __attribute__((ext_vector_type(2)));
struct EpiF32 {
    static constexpr bool PERM = false, AFTER_DRAIN = false;
    float* C; int ldc;
    __device__ __forceinline__ void operator()(const f32x4 (&acc)[2][2][4][2], const Unit& u, int wr, int wc, int fr, int fq) const {
        const int row0 = u.pm * BM + wr * 64 + fr, col0 = u.pn * BM + wc * 32 + 4 * fq;
#pragma unroll
        for (int ai = 0; ai < 2; ++ai)
#pragma unroll
            for (int m = 0; m < 4; ++m) { float* rowp = C + (size_t)(row0 + ai * HALF + m * 16) * ldc + col0;
#pragma unroll
                for (int bj = 0; bj < 2; ++bj)
#pragma unroll
                    for (int n = 0; n < 2; ++n) *(f32x4*)(rowp + bj * HALF + n * 16) = acc[ai][bj][m][n]; }
    }
};
__device__ __forceinline__ float row_rstd(const float* ssq, int row, int fq) {
    const f32x4* p = (const f32x4*)(ssq + (size_t)row * 32 + fq * 8);
    const f32x4 a = p[0], b = p[1];
    float s = ((a[0] + a[1]) + (a[2] + a[3])) + ((b[0] + b[1]) + (b[2] + b[3]));
    s += __shfl_xor(s, 16); s += __shfl_xor(s, 32);
    return 1.0f / sqrtf(s * (1.0f / 2048.0f) + 1e-6f);
}
__device__ __forceinline__ f32x4 swiglu4(f32x4 g, f32x4 u) {
    f32x4 o;
#pragma unroll
    for (int e = 0; e < 4; ++e) { const float t = __builtin_amdgcn_exp2f(g[e] * -1.4426950408889634f); o[e] = g[e] * __builtin_amdgcn_rcpf(1.0f + t) * u[e]; }
    return o;
}
struct EpiSwiglu {
    static constexpr bool PERM = true, AFTER_DRAIN = false;
    bf16_t* H; const float* ssq; mutable float rs[2][4]; mutable int last_pm;
    __device__ __forceinline__ void operator()(const f32x4 (&acc)[2][2][4][2], const Unit& u, int wr, int wc, int fr, int fq) const {
        const int row0 = u.pm * BM + wr * 64 + fr, col0 = u.pn * HALF + wc * 32 + 8 * fq;
        if (u.pm != last_pm) { last_pm = u.pm;
#pragma unroll
            for (int ai = 0; ai < 2; ++ai)
#pragma unroll
                for (int m = 0; m < 4; ++m) rs[ai][m] = row_rstd(ssq, row0 + ai * HALF + m * 16, fq); }
#pragma unroll
        for (int ai = 0; ai < 2; ++ai)
#pragma unroll
            for (int m = 0; m < 4; ++m) { const int row = row0 + ai * HALF + m * 16; const float r = rs[ai][m];
                const f32x4 h0 = swiglu4(acc[ai][0][m][0] * r, acc[ai][1][m][0] * r), h1 = swiglu4(acc[ai][0][m][1] * r, acc[ai][1][m][1] * r);
                u32x4 w; w.x = cvt_pk_bf16(h0[0], h0[1]); w.y = cvt_pk_bf16(h0[2], h0[3]); w.z = cvt_pk_bf16(h1[0], h1[1]); w.w = cvt_pk_bf16(h1[2], h1[3]);
                *(u32x4*)(H + (size_t)row * 5632 + col0) = w; }
    }
};
struct EpiProj {
    static constexpr bool PERM = true, AFTER_DRAIN = false;
    bf16_t* P; int ldc; const float* ssq; mutable float rs[2][4]; mutable int last_pm;
    __device__ __forceinline__ void operator()(const f32x4 (&acc)[2][2][4][2], const Unit& u, int wr, int wc, int fr, int fq) const {
        const int row0 = u.pm * BM + wr * 64 + fr, col0 = u.pn * BM + wc * 32 + 8 * fq;
        if (u.pm != last_pm) { last_pm = u.pm;
#pragma unroll
            for (int ai = 0; ai < 2; ++ai)
#pragma unroll
                for (int m = 0; m < 4; ++m) rs[ai][m] = row_rstd(ssq, row0 + ai * HALF + m * 16, fq); }
#pragma unroll
        for (int ai = 0; ai < 2; ++ai)
#pragma unroll
            for (int m = 0; m < 4; ++m) { const int row = row0 + ai * HALF + m * 16; const float r = rs[ai][m];
#pragma unroll
                for (int bj = 0; bj < 2; ++bj) { const f32x4 v0 = acc[ai][bj][m][0] * r, v1 = acc[ai][bj][m][1] * r;
                    u32x4 w; w.x = cvt_pk_bf16(v0[0], v0[1]); w.y = cvt_pk_bf16(v0[2], v0[3]); w.z = cvt_pk_bf16(v1[0], v1[1]); w.w = cvt_pk_bf16(v1[2], v1[3]);
                    *(u32x4*)(P + (size_t)row * ldc + col0 + bj * HALF) = w; } }
    }
};
struct EpiResid {
    static constexpr bool PERM = true, AFTER_DRAIN = false;
    const float* Xin; float* Xout; bf16_t* XB; float* ssq; float f;
    __device__ __forceinline__ void operator()(const f32x4 (&acc)[2][2][4][2], const Unit& u, int wr, int wc, int fr, int fq) const {
        const int row0 = u.pm * BM + wr * 64 + fr, col0 = u.pn * BM + wc * 32 + 8 * fq;
#pragma unroll
        for (int ai = 0; ai < 2; ++ai) {
            u32x4 xb[4][2];
            if (!Xin) {
#pragma unroll
                for (int m = 0; m < 4; ++m)
#pragma unroll
                    for (int bj = 0; bj < 2; ++bj) xb[m][bj] = *(const u32x4*)(XB + (size_t)(row0 + ai * HALF + m * 16) * 2048 + col0 + bj * HALF);
            }
#pragma unroll
            for (int m = 0; m < 4; ++m) { const int row = row0 + ai * HALF + m * 16; float ss = 0.f;
#pragma unroll
                for (int bj = 0; bj < 2; ++bj) { const size_t off = (size_t)row * 2048 + col0 + bj * HALF;
                    f32x4 x0, x1;
                    if (Xin) { x0 = *(const f32x4*)(Xin + off); x1 = *(const f32x4*)(Xin + off + 4); }
                    else { const u32x4 w = xb[m][bj];
                        x0 = (f32x4){__uint_as_float(w.x << 16), __uint_as_float(w.x & 0xffff0000u), __uint_as_float(w.y << 16), __uint_as_float(w.y & 0xffff0000u)};
                        x1 = (f32x4){__uint_as_float(w.z << 16), __uint_as_float(w.z & 0xffff0000u), __uint_as_float(w.w << 16), __uint_as_float(w.w & 0xffff0000u)}; }
                    x0 = x0 + acc[ai][bj][m][0] * f; x1 = x1 + acc[ai][bj][m][1] * f;
                    if (Xout) { *(f32x4*)(Xout + off) = x0; *(f32x4*)(Xout + off + 4) = x1; }
                    if (!Xout) { u32x4 w; w.x = cvt_pk_bf16(x0[0], x0[1]); w.y = cvt_pk_bf16(x0[2], x0[3]); w.z = cvt_pk_bf16(x1[0], x1[1]); w.w = cvt_pk_bf16(x1[2], x1[3]);
                        *(u32x4*)(XB + off) = w; }
                    ss += ((x0[0] * x0[0] + x0[1] * x0[1]) + (x0[2] * x0[2] + x0[3] * x0[3])) + ((x1[0] * x1[0] + x1[1] * x1[1]) + (x1[2] * x1[2] + x1[3] * x1[3])); }
                ss += __shfl_xor(ss, 16); ss += __shfl_xor(ss, 32);
                if (fq == 0 && !Xout) ssq[(size_t)row * 32 + u.pn * 4 + wc] = ss; }
        }
    }
};
struct MkvOrder {
    int c;
    __device__ __forceinline__ bool next(int i, Unit& u) const { if (i != 0 || c >= 8) return false; u.pm = c >> 2; u.pn = c; return true; }
    __device__ __forceinline__ void a_ready(const Unit&) const {}
    __device__ __forceinline__ void done(const Unit&) const {}
};
template <class Epi, class Sched, bool ALIGN_EPI = false, bool SP2 = false>
__device__ __forceinline__ void gemm_phase(PG8_LAS unsigned char* lds, const Gemm g, const Sched& S, const Epi& E) {
    int tid_ = threadIdx.x; asm volatile("" : "+v"(tid_));
    const int tid = tid_, wid = __builtin_amdgcn_readfirstlane(tid >> 6), lane = tid & 63, wr = wid >> 2, wc = wid & 3, fr = lane & 15, fq = lane >> 4;
    const int K = g.K, nt = K / BK;
    unsigned voffA[2], voffB[2];
#pragma unroll
    for (int i = 0; i < 2; ++i) { int R, C; stage_rc(tid * 16 + i * 8192, R, C); const int Rb = Epi::PERM ? ((R & ~31) + perm32(R & 31)) : R;
        voffA[i] = (unsigned)(R * K + C) * 2u; voffB[i] = (unsigned)(Rb * K + C) * 2u; }
    const size_t kstep = (size_t)(BK * 2);
    const size_t hstep = (size_t)HALF * K * 2;
    const size_t tstep = 2 * hstep;
    const unsigned ldsw = (unsigned)wid * 1024u;
    const int aoff = lds_byte(wr * 64 + fr, fq * 8), boff = lds_byte(wc * 32 + fr, fq * 8);
#define PG8_SA(b, h) (((b) * 2 + (h)) * HTB)
#define PG8_SB(b, h) ((4 + (b) * 2 + (h)) * HTB)
#define PG8_STAGE(bufoff, gbase, voff) do { _Pragma("unroll") for (int _i = 0; _i < 2; ++_i) \
        __builtin_amdgcn_global_load_lds((const unsigned*)((const char*)(gbase) + (voff)[_i]), (PG8_LAS unsigned*)(lds + (bufoff) + ldsw + _i * 8192), 16, 0, 0); } while (0)
#define PG8_LDA(dst, b, h) do { _Pragma("unroll") for (int m = 0; m < 4; ++m) _Pragma("unroll") for (int k = 0; k < 2; ++k) dst[m][k] = *(const PG8_LAS bf16x8*)(lds + PG8_SA(b, h) + aoff + m * 2048 + k * 1024); } while (0)
#define PG8_LDB(dst, b, h) do { _Pragma("unroll") for (int n = 0; n < 2; ++n) _Pragma("unroll") for (int k = 0; k < 2; ++k) dst[n][k] = *(const PG8_LAS bf16x8*)(lds + PG8_SB(b, h) + boff + n * 2048 + k * 1024); } while (0)
#define PG8_MMA(ai, bj, At, Bt) do { __builtin_amdgcn_s_setprio(1); _Pragma("unroll") for (int m = 0; m < 4; ++m) _Pragma("unroll") for (int n = 0; n < 2; ++n) _Pragma("unroll") for (int k = 0; k < 2; ++k) \
        acc[ai][bj][m][n] = __builtin_amdgcn_mfma_f32_16x16x32_bf16(Bt[n][k], At[m][k], acc[ai][bj][m][n], 0, 0, 0); __builtin_amdgcn_s_setprio(0); } while (0)
#define PG8_WAIT_V(n) asm volatile("s_waitcnt vmcnt(" #n ")" ::: "memory")
#define PG8_WAIT_L(n) asm volatile("s_waitcnt lgkmcnt(" #n ")" ::: "memory")
#define PG8_BAR __builtin_amdgcn_s_barrier()
#define PG8_SCHED __builtin_amdgcn_sched_barrier(0)
    Unit cur, nxt; int ui = 0;
    if (!S.next(0, cur)) return;
    f32x4 acc[2][2][4][2];
#pragma unroll
    for (int a = 0; a < 2; ++a)
#pragma unroll
        for (int b = 0; b < 2; ++b)
#pragma unroll
            for (int m = 0; m < 4; ++m)
#pragma unroll
                for (int n = 0; n < 2; ++n) acc[a][b][m][n] = (f32x4){0.f, 0.f, 0.f, 0.f};
    bf16x8 At[4][2], B0[2][2], B1[2][2];
    const char* cA = (const char*)g.A + (size_t)cur.pm * tstep; const char* cB = (const char*)g.Bt + (size_t)cur.pn * tstep;
    S.a_ready(cur);
    if constexpr (SP2) {
        PG8_STAGE(PG8_SB(0, 0), cB, voffB); PG8_STAGE(PG8_SB(0, 1), cB + hstep, voffB); PG8_STAGE(PG8_SA(0, 0), cA, voffA); PG8_STAGE(PG8_SA(0, 1), cA + hstep, voffA);
        if (wr == 1) PG8_BAR;
        PG8_WAIT_V(2); PG8_BAR;
        PG8_STAGE(PG8_SB(1, 0), cB + kstep, voffB); PG8_STAGE(PG8_SA(1, 0), cA + kstep, voffA); PG8_STAGE(PG8_SB(1, 1), cB + hstep + kstep, voffB);
        PG8_WAIT_V(6); PG8_BAR;
    } else {
        PG8_STAGE(PG8_SB(0, 0), cB, voffB); PG8_STAGE(PG8_SA(0, 0), cA, voffA); PG8_STAGE(PG8_SB(0, 1), cB + hstep, voffB); PG8_STAGE(PG8_SA(0, 1), cA + hstep, voffA);
        if (wr == 1) PG8_BAR;
        PG8_WAIT_V(4); PG8_BAR;
        PG8_STAGE(PG8_SB(1, 0), cB + kstep, voffB); PG8_STAGE(PG8_SA(1, 0), cA + kstep, voffA); PG8_STAGE(PG8_SB(1, 1), cB + hstep + kstep, voffB);
        PG8_WAIT_V(6); PG8_BAR;
    }
    for (;;) {
        const bool has_next = S.next(ui + 1, nxt);
        const char* nA = has_next ? (const char*)g.A + (size_t)nxt.pm * tstep : cA; const char* nB = has_next ? (const char*)g.Bt + (size_t)nxt.pn * tstep : cB;
        for (int t = 0; t < nt; t += 2) {
            const bool last = (t == nt - 2);
            const char* a1 = cA + (size_t)(t + 1) * kstep;
            const char* a2 = last ? nA : cA + (size_t)(t + 2) * kstep; const char* b2 = last ? nB : cB + (size_t)(t + 2) * kstep;
            const char* a3 = a2 + kstep; const char* b3 = b2 + kstep;
            if (last && has_next) S.a_ready(nxt);
            if constexpr (SP2) {
            PG8_LDB(B0, 0, 0); PG8_LDB(B1, 0, 1); PG8_SCHED; PG8_LDA(At, 0, 0); PG8_STAGE(PG8_SA(1, 1), a1 + hstep, voffA);
            PG8_WAIT_V(8); PG8_WAIT_L(0); PG8_BAR; PG8_MMA(0, 0, At, B0); PG8_MMA(0, 1, At, B1); PG8_BAR; PG8_SCHED;
            PG8_LDA(At, 0, 1); PG8_STAGE(PG8_SB(0, 0), b2, voffB); PG8_STAGE(PG8_SB(0, 1), b2 + hstep, voffB); PG8_STAGE(PG8_SA(0, 0), a2, voffA);
            PG8_WAIT_V(8); PG8_WAIT_L(0); PG8_BAR; PG8_MMA(1, 0, At, B0); PG8_MMA(1, 1, At, B1); PG8_BAR; PG8_SCHED;
            PG8_LDB(B0, 1, 0); PG8_LDB(B1, 1, 1); PG8_SCHED; PG8_LDA(At, 1, 0); PG8_STAGE(PG8_SA(0, 1), a2 + hstep, voffA);
            PG8_WAIT_V(8); PG8_WAIT_L(0); PG8_BAR; PG8_MMA(0, 0, At, B0); PG8_MMA(0, 1, At, B1); PG8_BAR; PG8_SCHED;
            PG8_LDA(At, 1, 1); PG8_STAGE(PG8_SB(1, 0), b3, voffB); PG8_STAGE(PG8_SB(1, 1), b3 + hstep, voffB); PG8_STAGE(PG8_SA(1, 0), a3, voffA);
            PG8_WAIT_V(8); PG8_WAIT_L(0); PG8_BAR; PG8_MMA(1, 0, At, B0); PG8_MMA(1, 1, At, B1); PG8_BAR; PG8_SCHED;
            } else {
            PG8_LDB(B0, 0, 0); PG8_SCHED; PG8_LDA(At, 0, 0); PG8_STAGE(PG8_SA(1, 1), a1 + hstep, voffA);
            PG8_WAIT_L(8); PG8_BAR; PG8_WAIT_L(0); PG8_MMA(0, 0, At, B0); PG8_BAR; PG8_SCHED;
            PG8_LDB(B1, 0, 1); PG8_STAGE(PG8_SB(0, 0), b2, voffB);
            PG8_BAR; PG8_WAIT_L(0); PG8_MMA(0, 1, At, B1); PG8_BAR;
            PG8_LDA(At, 0, 1); PG8_STAGE(PG8_SA(0, 0), a2, voffA);
            PG8_BAR; PG8_WAIT_L(0); PG8_MMA(1, 0, At, B0); PG8_BAR; PG8_SCHED;
            PG8_STAGE(PG8_SB(0, 1), b2 + hstep, voffB);
            PG8_WAIT_V(6); PG8_BAR; PG8_MMA(1, 1, At, B1); PG8_BAR;
            PG8_LDB(B0, 1, 0); PG8_SCHED; PG8_LDA(At, 1, 0); PG8_STAGE(PG8_SA(0, 1), a2 + hstep, voffA);
            PG8_WAIT_L(8); PG8_BAR; PG8_WAIT_L(0); PG8_MMA(0, 0, At, B0); PG8_BAR; PG8_SCHED;
            PG8_LDB(B1, 1, 1); PG8_STAGE(PG8_SB(1, 0), b3, voffB);
            PG8_BAR; PG8_WAIT_L(0); PG8_MMA(0, 1, At, B1); PG8_BAR;
            PG8_LDA(At, 1, 1); PG8_STAGE(PG8_SA(1, 0), a3, voffA);
            PG8_BAR; PG8_WAIT_L(0); PG8_MMA(1, 0, At, B0); PG8_BAR; PG8_SCHED;
            PG8_STAGE(PG8_SB(1, 1), b3 + hstep, voffB);
            PG8_WAIT_V(6); PG8_BAR; PG8_MMA(1, 1, At, B1); PG8_BAR;
            }
        }
        if constexpr (ALIGN_EPI) { if (wr == 0) PG8_BAR; }
        if constexpr (!Epi::AFTER_DRAIN) { E(acc, cur, wr, wc, fr, fq); S.done(cur); }
        if (!has_next) break;
#pragma unroll
        for (int a = 0; a < 2; ++a)
#pragma unroll
            for (int b = 0; b < 2; ++b)
#pragma unroll
                for (int m = 0; m < 4; ++m)
#pragma unroll
                    for (int n = 0; n < 2; ++n) acc[a][b][m][n] = (f32x4){0.f, 0.f, 0.f, 0.f};
        cur = nxt; cA = nA; cB = nB; ++ui;
        if constexpr (ALIGN_EPI) { if (wr == 1) PG8_BAR; }
    }
    PG8_WAIT_V(0);
    if constexpr (!ALIGN_EPI) { if (wr == 0) PG8_BAR; }
    PG8_BAR;
    if constexpr (Epi::AFTER_DRAIN) { E.fused(acc, cur, wr, wc, fr, fq, lds, wid, lane); S.done(cur); }
#undef PG8_SA
#undef PG8_SB
#undef PG8_STAGE
#undef PG8_LDA
#undef PG8_LDB
#undef PG8_MMA
#undef PG8_WAIT_V
#undef PG8_WAIT_L
#undef PG8_BAR
#undef PG8_SCHED
}
}

#define LAS __attribute__((address_space(3)))
typedef unsigned short bf16_t;
typedef short bf16x8 __attribute__((ext_vector_type(8)));
typedef short s16x4 __attribute__((ext_vector_type(4)));
typedef float f32x4 __attribute__((ext_vector_type(4)));
typedef float f32x2 __attribute__((ext_vector_type(2)));
typedef float f32x16 __attribute__((ext_vector_type(16)));
typedef unsigned u32x4 __attribute__((ext_vector_type(4)));
typedef unsigned u32x2 __attribute__((ext_vector_type(2)));
typedef __bf16 bf16x2_t __attribute__((ext_vector_type(2)));

constexpr int SEQ = 16384, DM = 2048, DFF = 5632, INW = 5120, NH = 8, HD = 128, NBLK = 64, BLKSZ = 256;
#ifndef EN_MASK
#define EN_MASK 0x1ff
#endif
constexpr bool EN_P0 = EN_MASK & 1, EN_P1 = EN_MASK & 2, EN_GU = EN_MASK & 4, EN_RES = EN_MASK & 8, EN_PROJ = EN_MASK & 16, EN_PRE = EN_MASK & 32, EN_GATE = EN_MASK & 64, EN_SEL = EN_MASK & 128, EN_OWN = EN_MASK & 256;
#ifndef MK_DUP
#define MK_DUP 0
#endif
constexpr int NPH = 22;
#ifndef MK_COOP
#define MK_COOP 1
#endif
constexpr size_t MiB = 1u << 20;
constexpr size_t WS_CNT = 0;
constexpr size_t WS_BAR = 16 * 1024;
constexpr size_t WS_KMEAN = 64 * 1024;
constexpr size_t WS_SSQ = 1 * MiB;
constexpr size_t WS_ROPE = 4 * MiB;
constexpr size_t WS_MEMB = 12 * MiB;
constexpr size_t WS_MKV = 14 * MiB;
constexpr size_t WS_ML = 18 * MiB;
constexpr size_t WS_WT = 22 * MiB;
constexpr size_t WT_LAYER = 160 * MiB, WT_GU1 = 0, WT_D1 = 44 * MiB, WT_IN = 66 * MiB, WT_OUT = 86 * MiB, WT_GU2 = 94 * MiB, WT_D2 = 138 * MiB;
constexpr size_t WS_XB = 350 * MiB;
constexpr size_t WS_LIST = WS_XB, WS_VT = WS_XB + 32 * MiB;
constexpr size_t WS_H = 414 * MiB;
constexpr size_t WS_MIX = 590 * MiB;
constexpr size_t WS_PART = 654 * MiB;
constexpr size_t WS_END = 750 * MiB;
constexpr int LDS_BYTES = 147456;
constexpr int KS_STRIDE = 272, VT_STRIDE = 528, LDS_KS = 0, LDS_VT = 256 * KS_STRIDE, LDS_MISC = 139264;
static_assert(LDS_VT + 128 * VT_STRIDE <= LDS_MISC, "lds map");

#define TID_LOCALS int tid_ = threadIdx.x; asm volatile("" : "+v"(tid_)); const int tid = tid_, lane = tid & 63, wave = __builtin_amdgcn_readfirstlane(tid >> 6), r32 = lane & 31, hi = lane >> 5; (void)r32; (void)hi; (void)wave; (void)lane;
struct Args { const void* in[19]; float* out; unsigned char* ws; float inv_freq[64]; int ph_lo, ph_hi; };

__device__ __forceinline__ unsigned cvtpk(float lo, float hi) { f32x2 v = {lo, hi}; bf16x2_t b = __builtin_convertvector(v, bf16x2_t); return __builtin_bit_cast(unsigned, b); }
__device__ __forceinline__ float bflo(unsigned w) { return __uint_as_float(w << 16); }
__device__ __forceinline__ float bfhi(unsigned w) { return __uint_as_float(w & 0xffff0000u); }
__device__ __forceinline__ float wave_sum(float v) {
#pragma unroll
    for (int o = 1; o < 64; o <<= 1) v += __shfl_xor(v, o);
    return v;
}
__device__ __forceinline__ int crow(int r, int hi) { return (r & 3) + 8 * (r >> 2) + 4 * hi; }
#define MFMA32(a, b, c) __builtin_amdgcn_mfma_f32_32x32x16_bf16((a), (b), (c), 0, 0, 0)

__device__ __forceinline__ void tr_item(const float* W, int K, int N, bf16_t* WT, const float* gain, int perm, LAS float* scr, int item, int lane) {
    const int nblk = N / 64, kb = item / nblk, nb = item % nblk, k0 = 64 * kb, n0 = 64 * nb, lr = lane >> 4, c4 = lane & 15;
    f32x4 v[16];
#pragma unroll
    for (int i = 0; i < 16; ++i) v[i] = *(const f32x4*)(W + (size_t)(k0 + lr + 4 * i) * N + n0 + 4 * c4);
    if (gain) {
#pragma unroll
        for (int i = 0; i < 16; ++i) v[i] = v[i] * gain[k0 + lr + 4 * i];
    }
#pragma unroll
    for (int i = 0; i < 16; ++i)
#pragma unroll
        for (int e = 0; e < 4; ++e) scr[(lr + 4 * i) * 65 + 4 * c4 + e] = v[i][e];
    asm volatile("s_waitcnt lgkmcnt(0)" ::: "memory");
    const int c = lane & 7;
#pragma unroll
    for (int j = 0; j < 8; ++j) { const int n = (lane >> 3) + 8 * j; const LAS float* s = scr + (8 * c) * 65 + n;
        u32x4 o; o.x = cvtpk(s[0 * 65], s[1 * 65]); o.y = cvtpk(s[2 * 65], s[3 * 65]); o.z = cvtpk(s[4 * 65], s[5 * 65]); o.w = cvtpk(s[6 * 65], s[7 * 65]);
        const int ncol = n0 + n; int drow = ncol;
        if (perm) { const int hf = ncol >= DFF ? 1 : 0, jj = ncol - hf * DFF; drow = 256 * (jj >> 7) + 128 * hf + (jj & 127); }
        *(u32x4*)(WT + (size_t)drow * K + k0 + 8 * c) = o; }
    asm volatile("s_waitcnt lgkmcnt(0)" ::: "memory");
}

template <bool CAUSAL>
__device__ __forceinline__ void attn_tile(const LAS unsigned char* Ks, const LAS unsigned char* Vts, const bf16x8 (&qf)[8], int qi, int r32, int hi, f32x16 (&O)[4], float& m2, float& l) {
    const float c = 0.08838834764831845f * 1.4426950408889634f;
    float m = -1.0e30f, lsum = 0.f;
#pragma unroll
    for (int d = 0; d < 4; ++d)
#pragma unroll
        for (int r = 0; r < 16; ++r) O[d][r] = 0.f;
#pragma unroll 1
    for (int hf = 0; hf < 2; ++hf) {
        f32x16 S[4];
#pragma unroll
        for (int s = 0; s < 4; ++s) {
            f32x16 a;
#pragma unroll
            for (int r = 0; r < 16; ++r) a[r] = 0.f;
            const LAS unsigned char* kp = Ks + (128 * hf + 32 * s + r32) * KS_STRIDE + 16 * hi;
#pragma unroll
            for (int d0 = 0; d0 < 8; ++d0) { const bf16x8 kf = *(const LAS bf16x8*)(kp + 32 * d0); a = MFMA32(kf, qf[d0], a); }
            S[s] = a;
            __builtin_amdgcn_sched_barrier(0);
        }
        float mx = -1.0e30f;
#pragma unroll
        for (int s = 0; s < 4; ++s)
#pragma unroll
            for (int r = 0; r < 16; ++r) { float v = S[s][r]; if (CAUSAL) { if (128 * hf + 32 * s + crow(r, hi) > qi) v = -INFINITY; S[s][r] = v; } mx = fmaxf(mx, v); }
        mx = fmaxf(mx, __shfl_xor(mx, 32));
        const float mn = fmaxf(m, mx * c), alpha = __builtin_amdgcn_exp2f(m - mn);
        m = mn; lsum *= alpha;
#pragma unroll
        for (int d = 0; d < 4; ++d)
#pragma unroll
            for (int r = 0; r < 16; ++r) O[d][r] *= alpha;
#pragma unroll
        for (int s = 0; s < 4; ++s)
#pragma unroll
            for (int r = 0; r < 16; ++r) { const float p = __builtin_amdgcn_exp2f(S[s][r] * c - mn); S[s][r] = p; lsum += p; }
#pragma unroll
        for (int s = 0; s < 4; ++s)
#pragma unroll
            for (int j = 0; j < 2; ++j) {
                u32x4 pw; pw.x = cvtpk(S[s][8 * j + 0], S[s][8 * j + 1]); pw.y = cvtpk(S[s][8 * j + 2], S[s][8 * j + 3]); pw.z = cvtpk(S[s][8 * j + 4], S[s][8 * j + 5]); pw.w = cvtpk(S[s][8 * j + 6], S[s][8 * j + 7]);
                const bf16x8 pf = __builtin_bit_cast(bf16x8, pw);
#pragma unroll
                for (int d = 0; d < 4; ++d) {
                    const LAS unsigned char* vp = Vts + (32 * d + r32) * VT_STRIDE + (128 * hf + 32 * s + 16 * j + 4 * hi) * 2;
                    const s16x4 lo = *(const LAS s16x4*)vp, h4 = *(const LAS s16x4*)(vp + 16);
                    const bf16x8 vf = __builtin_shufflevector(lo, h4, 0, 1, 2, 3, 4, 5, 6, 7);
                    O[d] = MFMA32(vf, pf, O[d]);
                }
                __builtin_amdgcn_sched_barrier(0);
            }
    }
    lsum += __shfl_xor(lsum, 32);
    m2 = m; l = lsum;
}
__device__ __forceinline__ void stage_kv(LAS unsigned char* lds, const bf16_t* Kg, int kpitch, const bf16_t* Vtg, int tid) {
#pragma unroll
    for (int i = 0; i < 8; ++i) { const int c = tid + 512 * i, row = c >> 4, ch = c & 15; *(LAS u32x4*)(lds + LDS_KS + row * KS_STRIDE + ch * 16) = *(const u32x4*)(Kg + (size_t)row * kpitch + ch * 8); }
#pragma unroll
    for (int i = 0; i < 8; ++i) { const int c = tid + 512 * i, row = c >> 5, ch = c & 31; *(LAS u32x4*)(lds + LDS_VT + row * VT_STRIDE + ch * 16) = *(const u32x4*)(Vtg + (size_t)row * 256 + ch * 8); }
}
__device__ __forceinline__ void store_orow(bf16_t* orow, const f32x16 (&O)[4], float sc, int hi, bool st) {
#pragma unroll
    for (int d = 0; d < 4; ++d)
#pragma unroll
        for (int k = 0; k < 2; ++k) {
            const unsigned x0 = cvtpk(O[d][8 * k + 0] * sc, O[d][8 * k + 1] * sc), x1 = cvtpk(O[d][8 * k + 2] * sc, O[d][8 * k + 3] * sc);
            const unsigned y0 = cvtpk(O[d][8 * k + 4] * sc, O[d][8 * k + 5] * sc), y1 = cvtpk(O[d][8 * k + 6] * sc, O[d][8 * k + 7] * sc);
            const auto r0 = __builtin_amdgcn_permlane32_swap(x0, y0, false, false), r1 = __builtin_amdgcn_permlane32_swap(x1, y1, false, false);
            u32x4 w; w.x = r0[0]; w.y = r1[0]; w.z = r0[1]; w.w = r1[1];
            if (st) *(u32x4*)(orow + 32 * d + 16 * k + 8 * hi) = w;
        }
}
__device__ __forceinline__ void addmul_prow(f32x16 (&O)[4], const bf16_t* pr, float wt, int hi) {
#pragma unroll
    for (int d = 0; d < 4; ++d)
#pragma unroll
        for (int k = 0; k < 2; ++k) {
            const u32x4 w = *(const u32x4*)(pr + 32 * d + 16 * k + 8 * hi);
            const auto r0 = __builtin_amdgcn_permlane32_swap(w.x, w.z, false, false), r1 = __builtin_amdgcn_permlane32_swap(w.y, w.w, false, false);
            O[d][8 * k + 0] += wt * bflo(r0[0]); O[d][8 * k + 1] += wt * bfhi(r0[0]); O[d][8 * k + 2] += wt * bflo(r1[0]); O[d][8 * k + 3] += wt * bfhi(r1[0]);
            O[d][8 * k + 4] += wt * bflo(r0[1]); O[d][8 * k + 5] += wt * bfhi(r0[1]); O[d][8 * k + 6] += wt * bflo(r1[1]); O[d][8 * k + 7] += wt * bfhi(r1[1]);
        }
}

__device__ __forceinline__ void norm_rope_block(const u32x4 (&a)[4], const u32x4 (&c)[4]  , bf16_t* obase, int opitch, const float* gain, const int* positions, const f32x4 (&rp)[16]  , int tok0, bool do_mean, float* kmean, LAS unsigned char* lds, int tid) {
    const int row = tid >> 1, hf = tid & 1, tok = tok0 + row, lane = tid & 63, wave = tid >> 6;
    float x1[32], x2[32]; float ss = 0.f;
#pragma unroll
    for (int i = 0; i < 4; ++i)
#pragma unroll
        for (int e = 0; e < 4; ++e) { x1[8 * i + 2 * e] = bflo(a[i][e]); x1[8 * i + 2 * e + 1] = bfhi(a[i][e]); x2[8 * i + 2 * e] = bflo(c[i][e]); x2[8 * i + 2 * e + 1] = bfhi(c[i][e]); }
#pragma unroll
    for (int i = 0; i < 32; ++i) ss += x1[i] * x1[i] + x2[i] * x2[i];
    ss += __shfl_xor(ss, 1);
    const float rstd = 1.0f / sqrtf(ss * (1.0f / 128.0f) + 1e-6f);
#pragma unroll
    for (int i = 0; i < 32; ++i) { const float n1 = x1[i] * rstd * gain[32 * hf + i], n2 = x2[i] * rstd * gain[64 + 32 * hf + i]; const float cs_x = rp[i >> 1][2 * (i & 1)], cs_y = rp[i >> 1][2 * (i & 1) + 1];
        x1[i] = n1 * cs_x - n2 * cs_y; x2[i] = n2 * cs_x + n1 * cs_y; }
#pragma unroll
    for (int i = 0; i < 4; ++i) { u32x4 w, v;
#pragma unroll
        for (int e = 0; e < 4; ++e) { w[e] = cvtpk(x1[8 * i + 2 * e], x1[8 * i + 2 * e + 1]); v[e] = cvtpk(x2[8 * i + 2 * e], x2[8 * i + 2 * e + 1]); }
        bf16_t* po = obase + (size_t)row * opitch; *(u32x4*)(po + 32 * hf + 8 * i) = w; *(u32x4*)(po + 64 + 32 * hf + 8 * i) = v; }
    if (do_mean) {
        LAS float* tile = (LAS float*)lds;
#pragma unroll
        for (int i = 0; i < 8; ++i) { *(LAS f32x4*)(tile + row * 132 + 32 * hf + 4 * i) = (f32x4){x1[4 * i], x1[4 * i + 1], x1[4 * i + 2], x1[4 * i + 3]};
                                      *(LAS f32x4*)(tile + row * 132 + 64 + 32 * hf + 4 * i) = (f32x4){x2[4 * i], x2[4 * i + 1], x2[4 * i + 2], x2[4 * i + 3]}; }
        __syncthreads();
        { const int d = tid & 127, q4 = tid >> 7; float sacc = 0.f;
#pragma unroll 16
          for (int r = 0; r < 64; ++r) sacc += tile[(64 * q4 + r) * 132 + d];
          LAS float* part = (LAS float*)(lds + LDS_MISC);
          part[q4 * 128 + d] = sacc; }
        __syncthreads();
        if (tid < 128) { LAS float* part = (LAS float*)(lds + LDS_MISC); kmean[tid] = ((part[tid] + part[128 + tid]) + (part[256 + tid] + part[384 + tid])) * (1.0f / 256.0f); }
        __syncthreads();
    }
}

#define XB_TMO      128
#define XB_XCNT(j)  (256  + 64 * (j))
#define XB_XSUB(j)  (1280 + 64 * (j))
#define XB_XGEN(j)  (2304 + 64 * (j))
#define XB_TOP      3328
#define XB_TOPGEN   3392
#define XCD_BAR_WORDS 3456
#define XB_SPIN_CAP (1u << 18)

__device__ __forceinline__ unsigned xb_ld(unsigned* p)              { return __hip_atomic_load(p, __ATOMIC_RELAXED, __HIP_MEMORY_SCOPE_AGENT); }
__device__ __forceinline__ unsigned xb_add(unsigned* p, unsigned v) { return __hip_atomic_fetch_add(p, v, __ATOMIC_RELAXED, __HIP_MEMORY_SCOPE_AGENT); }
__device__ __forceinline__ unsigned xb_xcc_id() { return (unsigned)__builtin_amdgcn_s_getreg((3 << 11) | 20) & 0xFu; }
#define XB_SPIN(cond, bar) do { unsigned _sp = 0; while (cond) { __builtin_amdgcn_s_sleep(1); \
    if ((++_sp & 255u) == 0u) { if (xb_ld(&(bar)[XB_TMO])) break; if (_sp > XB_SPIN_CAP) { atomicAdd(&(bar)[XB_TMO], 1u); break; } } } } while (0)

struct XcdBarrier {
    unsigned* bar; unsigned x;
    volatile LAS unsigned* st;
};

__device__ __forceinline__ XcdBarrier xcd_barrier_post(unsigned* bar, volatile LAS unsigned* st) {
    XcdBarrier b; b.bar = bar; b.x = xb_xcc_id(); b.st = st;
    if (threadIdx.x == 0) (void)xb_add(&bar[XB_XCNT(b.x)], 1u);
    return b;
}
__device__ __forceinline__ void xcd_barrier_complete(unsigned* bar, unsigned x, unsigned& nloc, unsigned& nx) {
    const unsigned G = gridDim.x * gridDim.y * gridDim.z;
    unsigned sum, cnt, mine, sp = 0u;
    for (;;) {
        sum = 0u; cnt = 0u; mine = 0u;
#pragma unroll
        for (unsigned j = 0; j < 16; ++j) { const unsigned c = xb_ld(&bar[XB_XCNT(j)]); sum += c; cnt += (c > 0u) ? 1u : 0u; mine = (j == x) ? c : mine; }
        if (sum == G) break;
        __builtin_amdgcn_s_sleep(1);
        if ((++sp & 255u) == 0u) { if (xb_ld(&bar[XB_TMO])) break; if (sp > XB_SPIN_CAP) { atomicAdd(&bar[XB_TMO], 1u); break; } }
    }
    nloc = mine > 0u ? mine : 1u; nx = cnt > 0u ? cnt : 1u;
}

__device__ __forceinline__ void xcd_barrier(const XcdBarrier& b) {
    asm volatile("s_waitcnt vmcnt(0)" ::: "memory");
    __syncthreads();
    if (threadIdx.x == 0) {
        unsigned* bar = b.bar;
        __builtin_amdgcn_s_waitcnt(0);
        unsigned nloc = b.st[0], nx = b.st[1];
        if (nloc == 0u) { xcd_barrier_complete(bar, b.x, nloc, nx); b.st[0] = nloc; b.st[1] = nx; }
        const unsigned old = xb_add(&bar[XB_XSUB(b.x)], 1u);
        const unsigned gen = old / nloc;
        if (old + 1u == (gen + 1u) * nloc) {
            __builtin_amdgcn_fence(__ATOMIC_RELEASE, "agent");
            asm volatile("s_waitcnt vmcnt(0)" ::: "memory");
            const unsigned og = xb_add(&bar[XB_TOP], 1u);
            const unsigned tg = og / nx;
            if (og + 1u == (tg + 1u) * nx) xb_add(&bar[XB_TOPGEN], 1u);
            else XB_SPIN(xb_ld(&bar[XB_TOPGEN]) == tg, bar);
            __builtin_amdgcn_fence(__ATOMIC_ACQUIRE, "agent");
            xb_add(&bar[XB_XGEN(b.x)], 1u);
            asm volatile("s_waitcnt vmcnt(0)" ::: "memory");
        } else {
            XB_SPIN(xb_ld(&bar[XB_XGEN(b.x)]) == gen, bar);
            __builtin_amdgcn_fence(__ATOMIC_ACQUIRE, "agent");
            asm volatile("s_waitcnt vmcnt(0)" ::: "memory");
        }
    }
    __syncthreads();
}

__global__ void __launch_bounds__(512, 2) mk_fwd(Args a) {
    extern __shared__ __attribute__((aligned(16))) unsigned char lds_raw[];
    LAS unsigned char* lds = (LAS unsigned char*)lds_raw;
    cg::grid_group grid = cg::this_grid();
    volatile LAS unsigned* bst = (volatile LAS unsigned*)(lds + LDS_BYTES - 16);
    if (threadIdx.x < 2) bst[threadIdx.x] = 0u;
    __syncthreads();
    XcdBarrier bar; bar.bar = nullptr; bar.x = 0; bar.st = bst;
    int redo_ = 0;
    for (int ph = a.ph_lo; ph < a.ph_hi; ++ph) {
        int bid_ = blockIdx.x, G_ = gridDim.x; asm volatile("" : "+s"(bid_), "+s"(G_));
        const int G = G_, bid = bid_;
        unsigned char* ws = a.ws; asm volatile("" : "+s"(ws));
        const float* x_in = (const float*)a.in[0]; const float* mem = (const float*)a.in[1]; const int* positions = (const int*)a.in[2];
        float* X = a.out;
        unsigned* CNT = (unsigned*)(ws + WS_CNT); float* KMEAN = (float*)(ws + WS_KMEAN); float* SSQ = (float*)(ws + WS_SSQ); f32x2* ROPE = (f32x2*)(ws + WS_ROPE);
        bf16_t* MEMB = (bf16_t*)(ws + WS_MEMB); float* MKV = (float*)(ws + WS_MKV); f32x2* ML = (f32x2*)(ws + WS_ML);
        bf16_t* XB = (bf16_t*)(ws + WS_XB); unsigned* LIST = (unsigned*)a.out; bf16_t* VT = (bf16_t*)((unsigned char*)a.out + 32 * MiB);
        bf16_t* H = (bf16_t*)(ws + WS_H); bf16_t* PROJ = (bf16_t*)(ws + WS_H); bf16_t* MIX = (bf16_t*)(ws + WS_MIX); bf16_t* PART = (bf16_t*)(ws + WS_PART);
        bf16_t* WT_MKV = (bf16_t*)(ws + WS_WT);

        const int s_ = ph >= 2 ? (ph - 2) % 10 : -1;
        const int nrep = (((MK_DUP & 1) && ph == 0) || ((MK_DUP & 2) && (s_ == 5 || s_ == 6)) || ((MK_DUP & 4) && (s_ == 0 || s_ == 8)) || ((MK_DUP & 8) && s_ == 2) || ((MK_DUP & 16) && ph == 1) || ((MK_DUP & 32) && ph == 3) || ((MK_DUP & 64) && (s_ == 1 || s_ == 7 || s_ == 9)) || ((MK_DUP & 128) && s_ == 3)) ? 2 : 1;
        for (int rep = 0; rep < nrep; ++rep) {
        if (rep) __syncthreads();
        if (EN_P0 && ph == 0) {
            TID_LOCALS
            LAS float* scr = (LAS float*)(lds + wave * 16640);
            const int gw = bid * 8 + wave, NGW = G * 8;
            constexpr int I_MKV = 32 * 16;
            for (int it = gw; it < 2 * I_MKV; it += NGW) { const int l = it >= I_MKV ? 1 : 0, r = it - l * I_MKV;
                tr_item((const float*)a.in[12] + (size_t)l * DM * 1024, DM, 1024, WT_MKV + (size_t)l * 1024 * DM, nullptr, 0, scr, r, lane); }
            for (int mr = gw; mr < 512; mr += NGW) {
                const int ml = mr >> 8;
                const f32x4* xr = (const f32x4*)(mem + (size_t)(mr & 255) * DM) + lane;
                f32x4 v[8]; float ss = 0.f;
#pragma unroll
                for (int j = 0; j < 8; ++j) { v[j] = xr[64 * j]; ss += (v[j][0] * v[j][0] + v[j][1] * v[j][1]) + (v[j][2] * v[j][2] + v[j][3] * v[j][3]); }
                ss = wave_sum(ss);
                const float rstd = 1.0f / sqrtf(ss * (1.0f / DM) + 1e-6f); const f32x4* gn = (const f32x4*)((const float*)a.in[11] + ml * DM) + lane;
                u32x2* o = (u32x2*)(MEMB + (size_t)mr * DM) + lane;
#pragma unroll
                for (int j = 0; j < 8; ++j) { const f32x4 g = gn[64 * j]; o[64 * j] = (u32x2){cvtpk(v[j][0] * rstd * g[0], v[j][1] * rstd * g[1]), cvtpk(v[j][2] * rstd * g[2], v[j][3] * rstd * g[3])}; }
            }
            if (bid == 0) { CNT[tid] = 0u; CNT[512 + tid] = 0u; CNT[1024 + tid] = 0u; unsigned* bw = (unsigned*)(ws + WS_BAR); for (int i = tid; i < XCD_BAR_WORDS; i += 512) bw[i] = 0u; }
        } else if (EN_P1 && ph == 1 && bid < 8) {
            pg8::Gemm g{MEMB, WT_MKV, 512, 2048, DM}; pg8::MkvOrder S{bid}; pg8::EpiF32 E{MKV, 2048};
            pg8::gemm_phase<pg8::EpiF32, pg8::MkvOrder, true, true>(lds, g, S, E);
        } else if (EN_P0 && ph == 1) {
            TID_LOCALS
            LAS float* scr = (LAS float*)(lds + wave * 16640);
            const int gw = (bid - 8) * 8 + wave, NGW = (G - 8) * 8;
            constexpr int I_GU = 32 * 176, I_D = 88 * 32, I_IN = 32 * 80, I_OUT = 32 * 32, I_LAYER = 2 * I_GU + 2 * I_D + I_IN + I_OUT;
            for (int it = gw; it < 2 * I_LAYER; it += NGW) {
                const int l = it >= I_LAYER ? 1 : 0; int r = it - l * I_LAYER;
                bf16_t* wl = (bf16_t*)(ws + WS_WT + 8 * MiB + (size_t)l * WT_LAYER);
                if (r < I_GU) { tr_item((const float*)a.in[4] + (size_t)l * DM * 2 * DFF, DM, 2 * DFF, (bf16_t*)((unsigned char*)wl + WT_GU1), (const float*)a.in[3] + l * DM, 1, scr, r, lane); continue; } r -= I_GU;
                if (r < I_GU) { tr_item((const float*)a.in[17] + (size_t)l * DM * 2 * DFF, DM, 2 * DFF, (bf16_t*)((unsigned char*)wl + WT_GU2), (const float*)a.in[16] + l * DM, 1, scr, r, lane); continue; } r -= I_GU;
                if (r < I_D) { tr_item((const float*)a.in[5] + (size_t)l * DFF * DM, DFF, DM, (bf16_t*)((unsigned char*)wl + WT_D1), nullptr, 0, scr, r, lane); continue; } r -= I_D;
                if (r < I_D) { tr_item((const float*)a.in[18] + (size_t)l * DFF * DM, DFF, DM, (bf16_t*)((unsigned char*)wl + WT_D2), nullptr, 0, scr, r, lane); continue; } r -= I_D;
                if (r < I_IN) { tr_item((const float*)a.in[7] + (size_t)l * DM * INW, DM, INW, (bf16_t*)((unsigned char*)wl + WT_IN), (const float*)a.in[6] + l * DM, 0, scr, r, lane); continue; } r -= I_IN;
                tr_item((const float*)a.in[15] + (size_t)l * DM * DM, DM, DM, (bf16_t*)((unsigned char*)wl + WT_OUT), nullptr, 0, scr, r, lane);
            }
            for (int i = (bid - 8) * 512 + tid; i < SEQ * 64; i += (G - 8) * 512) {
                const int t = i >> 6, fi = i & 63; const float ang = (float)positions[t] * a.inv_freq[fi];
                double rev = (double)ang * 0.15915494309189535; rev -= __builtin_rint(rev); const float fr = (float)rev;
                ROPE[i] = (f32x2){__builtin_amdgcn_cosf(fr), __builtin_amdgcn_sinf(fr)};
            }
            for (int row = gw; row < SEQ; row += NGW) {
                const f32x4* xr = (const f32x4*)(x_in + (size_t)row * DM) + lane;
                f32x4 v[8]; float ss = 0.f;
#pragma unroll
                for (int j = 0; j < 8; ++j) { v[j] = xr[64 * j]; ss += (v[j][0] * v[j][0] + v[j][1] * v[j][1]) + (v[j][2] * v[j][2] + v[j][3] * v[j][3]); }
                ss = wave_sum(ss);
                u32x2* o = (u32x2*)(XB + (size_t)row * DM) + lane;
#pragma unroll
                for (int j = 0; j < 8; ++j) o[64 * j] = (u32x2){cvtpk(v[j][0], v[j][1]), cvtpk(v[j][2], v[j][3])};
                if (lane < 32) SSQ[(size_t)row * 32 + lane] = lane == 0 ? ss : 0.f;
            }
        } else {
            const int l = (ph - 2) / 10, s = (ph - 2) % 10;
            unsigned char* wl = ws + WS_WT + 8 * MiB + (size_t)l * WT_LAYER;
            if (EN_GU && (s == 0 || s == 8)) {
                pg8::Gemm g{XB, (const bf16_t*)(wl + (s == 0 ? WT_GU1 : WT_GU2)), SEQ, 2 * DFF, DM}; pg8::StaticOrder S; S.init(SEQ, 2 * DFF, G, bid);
                pg8::EpiSwiglu E{H, SSQ, {{0.f, 0.f, 0.f, 0.f}, {0.f, 0.f, 0.f, 0.f}}, -1};
                pg8::gemm_phase<pg8::EpiSwiglu, pg8::StaticOrder, true, true>(lds, g, S, E);
            } else if (EN_RES && (s == 1 || s == 7 || s == 9)) {
                const bool isout = (s == 7);
                pg8::Gemm g{isout ? MIX : H, (const bf16_t*)(wl + (s == 1 ? WT_D1 : (isout ? WT_OUT : WT_D2))), SEQ, DM, isout ? DM : DFF}; pg8::StaticOrder S; S.init(SEQ, DM, G, bid);
                pg8::EpiResid E{(l == 0 && s == 1) ? x_in : nullptr, (ph == NPH - 1) ? X : nullptr, XB, SSQ, ((MK_DUP & 64) && rep == 0) ? 0.0f : (isout ? 1.0f : 0.5f)};
                pg8::gemm_phase<pg8::EpiResid, pg8::StaticOrder, true, true>(lds, g, S, E);
            } else if (EN_PROJ && s == 2) {
                pg8::Gemm g{XB, (const bf16_t*)(wl + WT_IN), SEQ, INW, DM}; pg8::StaticOrder S; S.init(SEQ, INW, G, bid);
                pg8::EpiProj E{PROJ, INW, SSQ, {{0.f, 0.f, 0.f, 0.f}, {0.f, 0.f, 0.f, 0.f}}, -1};
                pg8::gemm_phase<pg8::EpiProj, pg8::StaticOrder, true, true>(lds, g, S, E);
            } else if (EN_PRE && s == 3) {
                for (int it = bid; it < 1024; it += G) {
                    const int w = it & 255, kk = it >> 8, b = w & 63, sl = (w >> 6) + 4 * kk, tok0 = 256 * b;
                    if (sl < 8) {
                        TID_LOCALS
                        const int h = sl;
                        u32x4 qa[4], qc[4], ka[4], kc[4];
                        { const bf16_t* pq = PROJ + (size_t)(tok0 + (tid >> 1)) * INW + 128 * h + 32 * (tid & 1); const bf16_t* pk = pq + 1024;
#pragma unroll
                          for (int i = 0; i < 4; ++i) { qa[i] = *(const u32x4*)(pq + 8 * i); qc[i] = *(const u32x4*)(pq + 64 + 8 * i); ka[i] = *(const u32x4*)(pk + 8 * i); kc[i] = *(const u32x4*)(pk + 64 + 8 * i); } }
                        const int dch = tid & 15, tg = tid >> 4;
                        const bf16_t* vsrc = PROJ + (size_t)(tok0 + 8 * tg) * INW + 2048 + 128 * h + 8 * dch;
                        u32x4 rw[8];
#pragma unroll
                        for (int e = 0; e < 8; ++e) rw[e] = *(const u32x4*)(vsrc + (size_t)e * INW);
                        {
                        const bool dummy_ = (MK_DUP & 128) && rep == 0; bf16_t* ob_ = dummy_ ? MIX + (size_t)tok0 * DM + 128 * h : nullptr;
                        f32x4 rp[16]; { const f32x4* r4 = (const f32x4*)(ROPE + (size_t)(tok0 + (tid >> 1)) * 64 + 32 * (tid & 1));
#pragma unroll
                          for (int i = 0; i < 16; ++i) rp[i] = r4[i]; }
                        norm_rope_block(qa, qc, dummy_ ? ob_ : PROJ + (size_t)tok0 * INW + 128 * h, dummy_ ? DM : INW, (const float*)a.in[8] + l * HD, positions, rp, tok0, false, nullptr, lds, tid);
                        norm_rope_block(ka, kc, dummy_ ? ob_ : PROJ + (size_t)tok0 * INW + 1024 + 128 * h, dummy_ ? DM : INW, (const float*)a.in[9] + l * HD, positions, rp, tok0, true, KMEAN + (size_t)(h * 64 + b) * 128, lds, tid);
                        }
                        bf16_t* vdst = VT + ((size_t)(h * 64 + b) * 128 + 8 * dch) * 256 + 8 * tg;
#pragma unroll
                        for (int c = 0; c < 8; ++c) { u32x4 o;
#pragma unroll
                            for (int e2 = 0; e2 < 4; ++e2) { const unsigned lo = rw[2 * e2][c >> 1], hh = rw[2 * e2 + 1][c >> 1];
                                o[e2] = (c & 1) ? ((lo >> 16) | (hh & 0xffff0000u)) : ((lo & 0xffffu) | (hh << 16)); }
                            *(u32x4*)(vdst + (size_t)c * 256) = o; }
                    } else if (sl < 12) {
                        TID_LOCALS
                        const int g = sl - 8, ch = tid & 15, tl = tid >> 4, c0 = 128 * g + 8 * ch, t0 = tok0 + 8 * tl;
                        const float* cw = (const float*)a.in[10] + l * 3 * 512 + c0;
                        float w0[8], w1[8], w2[8];
#pragma unroll
                        for (int e = 0; e < 8; ++e) { w0[e] = cw[e]; w1[e] = cw[512 + e]; w2[e] = cw[1024 + e]; }
                        float um2[8], um1[8];
#pragma unroll
                        for (int e = 0; e < 8; ++e) { um2[e] = 0.f; um1[e] = 0.f; }
                        if (t0 >= 2) {
                            const u32x4 c2 = *(const u32x4*)(PROJ + (size_t)(t0 - 2) * INW + 3584 + c0), x2 = *(const u32x4*)(PROJ + (size_t)(t0 - 2) * INW + 4096 + c0);
                            const u32x4 c1 = *(const u32x4*)(PROJ + (size_t)(t0 - 1) * INW + 3584 + c0), x1 = *(const u32x4*)(PROJ + (size_t)(t0 - 1) * INW + 4096 + c0);
#pragma unroll
                            for (int e = 0; e < 4; ++e) { um2[2 * e] = bflo(c2[e]) * bflo(x2[e]); um2[2 * e + 1] = bfhi(c2[e]) * bfhi(x2[e]); um1[2 * e] = bflo(c1[e]) * bflo(x1[e]); um1[2 * e + 1] = bfhi(c1[e]) * bfhi(x1[e]); }
                        }
#pragma unroll
                        for (int k = 0; k < 8; ++k) { const size_t ro = (size_t)(t0 + k) * INW;
                            const u32x4 cb = *(const u32x4*)(PROJ + ro + 3072 + c0), cc = *(const u32x4*)(PROJ + ro + 3584 + c0), cx = *(const u32x4*)(PROJ + ro + 4096 + c0);
                            float uc[8], y[8];
#pragma unroll
                            for (int e = 0; e < 4; ++e) { uc[2 * e] = bflo(cc[e]) * bflo(cx[e]); uc[2 * e + 1] = bfhi(cc[e]) * bfhi(cx[e]); }
#pragma unroll
                            for (int e = 0; e < 8; ++e) y[e] = w0[e] * um2[e] + w1[e] * um1[e] + w2[e] * uc[e];
                            u32x4 o;
#pragma unroll
                            for (int e = 0; e < 4; ++e) o[e] = cvtpk(y[2 * e] * bflo(cb[e]), y[2 * e + 1] * bfhi(cb[e]));
                            *(u32x4*)(MIX + (size_t)(t0 + k) * DM + 1024 + c0) = o;
#pragma unroll
                            for (int e = 0; e < 8; ++e) { um2[e] = um1[e]; um1[e] = uc[e]; } }
                    } else {
                        TID_LOCALS
                        const int hm = sl - 12;
                        { const int m = tid >> 1, hf = tid & 1;
                          const f32x4* kr = (const f32x4*)(MKV + (size_t)(256 * l + m) * 2048 + 1024 * l + 128 * hm + 64 * hf);
                          const f32x4* gk = (const f32x4*)((const float*)a.in[14] + l * HD + 64 * hf);
                          f32x4 v[16]; float ss = 0.f;
#pragma unroll
                          for (int i = 0; i < 16; ++i) { v[i] = kr[i]; ss += (v[i][0] * v[i][0] + v[i][1] * v[i][1]) + (v[i][2] * v[i][2] + v[i][3] * v[i][3]); }
                          ss += __shfl_xor(ss, 1);
                          const float rstd = 1.0f / sqrtf(ss * (1.0f / 128.0f) + 1e-6f);
#pragma unroll
                          for (int i = 0; i < 8; ++i) { const f32x4 g0 = gk[2 * i], g1 = gk[2 * i + 1]; const f32x4 p0 = v[2 * i] * rstd * g0, p1 = v[2 * i + 1] * rstd * g1;
                              u32x4 o; o.x = cvtpk(p0[0], p0[1]); o.y = cvtpk(p0[2], p0[3]); o.z = cvtpk(p1[0], p1[1]); o.w = cvtpk(p1[2], p1[3]);
                              *(LAS u32x4*)(lds + LDS_KS + m * KS_STRIDE + 128 * hf + 16 * i) = o; }
                          const f32x4* vr = kr + 128;
#pragma unroll
                          for (int i = 0; i < 16; ++i) { const f32x4 vv = vr[i];
#pragma unroll
                              for (int e = 0; e < 4; ++e) *(LAS bf16_t*)(lds + LDS_VT + (64 * hf + 4 * i + e) * VT_STRIDE + 2 * m) = (bf16_t)(cvtpk(vv[e], 0.f) & 0xffffu); }
                        }
                        __syncthreads();
                        const int tok = tok0 + 32 * wave + r32;
                        const bf16_t* qrow = PROJ + (size_t)tok * INW + 4608 + 128 * hm + 8 * hi;
                        const float* gq = (const float*)a.in[13] + l * HD + 8 * hi;
                        u32x4 qr[8]; float ss = 0.f;
#pragma unroll
                        for (int d0 = 0; d0 < 8; ++d0) { qr[d0] = *(const u32x4*)(qrow + 16 * d0);
#pragma unroll
                            for (int e = 0; e < 4; ++e) { const float lo = bflo(qr[d0][e]), hh = bfhi(qr[d0][e]); ss += lo * lo + hh * hh; } }
                        ss += __shfl_xor(ss, 32);
                        const float rstd = 1.0f / sqrtf(ss * (1.0f / 128.0f) + 1e-6f);
                        bf16x8 qf[8];
#pragma unroll
                        for (int d0 = 0; d0 < 8; ++d0) { u32x4 o;
#pragma unroll
                            for (int e = 0; e < 4; ++e) o[e] = cvtpk(bflo(qr[d0][e]) * rstd * gq[16 * d0 + 2 * e], bfhi(qr[d0][e]) * rstd * gq[16 * d0 + 2 * e + 1]);
                            qf[d0] = __builtin_bit_cast(bf16x8, o); }
                        f32x16 O[4]; float m2, ll;
                        attn_tile<false>(lds + LDS_KS, lds + LDS_VT, qf, 0, r32, hi, O, m2, ll);
                        store_orow(MIX + (size_t)tok * DM + 1536 + 128 * hm, O, 1.0f / ll, hi, true);
                        __syncthreads();
                    }
                }
            } else if (EN_GATE && s == 4) {
                for (int it = bid; it < 512; it += G) {
                    TID_LOCALS
                    const int h = it & 7, qc = it >> 3;
                    if (qc == 0) continue;
                    { const int j = tid >> 3, dc = (tid & 7) * 16; const f32x4* src = (const f32x4*)(KMEAN + ((size_t)h * 64 + j) * 128 + dc);
                      u32x4 hw[2], lw[2];
#pragma unroll
                      for (int i = 0; i < 4; ++i) { const f32x4 v = src[i]; float r_[4];
#pragma unroll
                          for (int e = 0; e < 4; ++e) { const unsigned hb = cvtpk(v[e], 0.f) & 0xffffu; r_[e] = v[e] - __uint_as_float(hb << 16); }
                          hw[i >> 1][2 * (i & 1)] = cvtpk(v[0], v[1]); hw[i >> 1][2 * (i & 1) + 1] = cvtpk(v[2], v[3]);
                          lw[i >> 1][2 * (i & 1)] = cvtpk(r_[0], r_[1]); lw[i >> 1][2 * (i & 1) + 1] = cvtpk(r_[2], r_[3]); }
                      *(LAS u32x4*)(lds + j * KS_STRIDE + dc * 2) = hw[0]; *(LAS u32x4*)(lds + j * KS_STRIDE + dc * 2 + 16) = hw[1];
                      *(LAS u32x4*)(lds + 64 * KS_STRIDE + j * KS_STRIDE + dc * 2) = lw[0]; *(LAS u32x4*)(lds + 64 * KS_STRIDE + j * KS_STRIDE + dc * 2 + 16) = lw[1]; }
                    __syncthreads();
                    const int tok = 256 * qc + 32 * wave + r32;
                    const bf16_t* qrow = PROJ + (size_t)tok * INW + 128 * h + 8 * hi;
                    bf16x8 qf[8];
#pragma unroll
                    for (int d0 = 0; d0 < 8; ++d0) qf[d0] = *(const bf16x8*)(qrow + 16 * d0);
                    float b0 = -INFINITY, b1 = -INFINITY, b2 = -INFINITY; int i0 = 0, i1 = 0, i2 = 0;
#pragma unroll
                    for (int jt = 0; jt < 2; ++jt) {
                        if (jt == 0 || qc > 32) {
                            f32x16 g;
#pragma unroll
                            for (int r = 0; r < 16; ++r) g[r] = 0.f;
                            const LAS unsigned char* kp = lds + (32 * jt + r32) * KS_STRIDE + 16 * hi;
#pragma unroll
                            for (int d0 = 0; d0 < 8; ++d0) { const bf16x8 kh = *(const LAS bf16x8*)(kp + 32 * d0), kl = *(const LAS bf16x8*)(kp + 64 * KS_STRIDE + 32 * d0);
                                g = MFMA32(kh, qf[d0], g); g = MFMA32(kl, qf[d0], g); }
#pragma unroll
                            for (int r = 0; r < 16; ++r) { const int j = 32 * jt + crow(r, hi); const float v = g[r];
                                if (j < qc) {
                                    if (v > b0) { b2 = b1; i2 = i1; b1 = b0; i1 = i0; b0 = v; i0 = j; }
                                    else if (v > b1) { b2 = b1; i2 = i1; b1 = v; i1 = j; }
                                    else if (v > b2) { b2 = v; i2 = j; } } }
                        }
                    }
                    { const float o0 = __shfl_xor(b0, 32), o1 = __shfl_xor(b1, 32), o2 = __shfl_xor(b2, 32); const int p0 = __shfl_xor(i0, 32), p1 = __shfl_xor(i1, 32), p2 = __shfl_xor(i2, 32);
#define MK_INS(v, j) do { const float v_ = (v); const int j_ = (j); \
                          if (v_ > b0 || (v_ == b0 && j_ < i0)) { b2 = b1; i2 = i1; b1 = b0; i1 = i0; b0 = v_; i0 = j_; } \
                          else if (v_ > b1 || (v_ == b1 && j_ < i1)) { b2 = b1; i2 = i1; b1 = v_; i1 = j_; } \
                          else if (v_ > b2 || (v_ == b2 && j_ < i2)) { b2 = v_; i2 = j_; } } while (0)
                      MK_INS(o0, p0); MK_INS(o1, p1); MK_INS(o2, p2);
#undef MK_INS
                    }
                    LAS unsigned* cntl = (LAS unsigned*)(lds + LDS_MISC); LAS unsigned* basel = cntl + 64;
                    if (tid < 64) cntl[tid] = 0u;
                    __syncthreads();
                    unsigned r0 = 0u, r1 = 0u, r2 = 0u;
                    if (hi == 0) { r0 = atomicAdd((unsigned*)(cntl + i0), 1u); if (qc > 1) r1 = atomicAdd((unsigned*)(cntl + i1), 1u); if (qc > 2) r2 = atomicAdd((unsigned*)(cntl + i2), 1u); }
                    __syncthreads();
                    if (tid < 64) { const unsigned n = cntl[tid]; basel[tid] = n ? atomicAdd(CNT + l * 512 + h * 64 + tid, n) : 0u; }
                    __syncthreads();
                    if (hi == 0) {
                        LIST[(size_t)(h * 64 + i0) * SEQ + basel[i0] + r0] = ((unsigned)tok << 2) | 0u;
                        if (qc > 1) LIST[(size_t)(h * 64 + i1) * SEQ + basel[i1] + r1] = ((unsigned)tok << 2) | 1u;
                        if (qc > 2) LIST[(size_t)(h * 64 + i2) * SEQ + basel[i2] + r2] = ((unsigned)tok << 2) | 2u;
                    }
                    __syncthreads();
                }
            } else if (EN_SEL && s == 5) {
                LAS int* pre = (LAS int*)(lds + LDS_MISC); LAS int* wtot = (LAS int*)(lds + LDS_MISC + 2048);
                { TID_LOCALS
                  const int mycnt = (int)CNT[l * 512 + tid];
                  int v = (mycnt + 255) >> 8;
#pragma unroll
                  for (int o = 1; o < 64; o <<= 1) { const int t = __shfl_up(v, o); if (lane >= o) v += t; }
                  if (lane == 63) wtot[wave] = v;
                  __syncthreads();
                  int add = 0;
#pragma unroll
                  for (int w = 0; w < 8; ++w) add += (w < wave) ? wtot[w] : 0;
                  pre[tid] = v + add;
                  __syncthreads(); }
                const int total = pre[511];
                const int vcu = (G % 8 == 0) ? (bid % 8) * (G / 8) + bid / 8 : bid;
                for (int it = vcu; it < total; it += G) {
                    TID_LOCALS
                    int lo = 0, hh = 511;
                    while (lo < hh) { const int mid = (lo + hh) >> 1; if (pre[mid] > it) hh = mid; else lo = mid + 1; }
                    const int p = lo, chunk = it - (p ? pre[p - 1] : 0), h = p >> 6, b = p & 63;
                    const int pc = (int)CNT[l * 512 + p];
                    stage_kv(lds, PROJ + (size_t)(256 * b) * INW + 1024 + 128 * h, INW, VT + (size_t)(h * 64 + b) * 128 * 256, tid);
                    __syncthreads();
                    const int e = chunk * 256 + 32 * wave + r32; const bool valid = e < pc;
                    const unsigned ent = LIST[(size_t)p * SEQ + (valid ? e : 0)]; const int tok = (int)(ent >> 2), slot = (int)(ent & 3u);
                    const bf16_t* qrow = PROJ + (size_t)tok * INW + 128 * h + 8 * hi;
                    bf16x8 qf[8];
#pragma unroll
                    for (int d0 = 0; d0 < 8; ++d0) qf[d0] = *(const bf16x8*)(qrow + 16 * d0);
                    f32x16 O[4]; float m2, ll;
                    attn_tile<false>(lds + LDS_KS, lds + LDS_VT, qf, 0, r32, hi, O, m2, ll);
                    { const size_t pi = ((size_t)h * SEQ + tok) * 3 + slot;
                      store_orow(PART + pi * 128, O, 1.0f / ll, hi, valid);
                      if (valid && hi == 0) ML[pi] = (f32x2){m2, ll}; }
                    __syncthreads();
                }
            } else if (EN_OWN && s == 6) {
                for (int it = bid; it < 512; it += G) {
                    TID_LOCALS
                    const int h = it & 7, b = it >> 3;
                    stage_kv(lds, PROJ + (size_t)(256 * b) * INW + 1024 + 128 * h, INW, VT + (size_t)(h * 64 + b) * 128 * 256, tid);
                    __syncthreads();
                    const int qi = 32 * wave + r32, tok = 256 * b + qi;
                    const bf16_t* qrow = PROJ + (size_t)tok * INW + 128 * h + 8 * hi;
                    bf16x8 qf[8];
#pragma unroll
                    for (int d0 = 0; d0 < 8; ++d0) qf[d0] = *(const bf16x8*)(qrow + 16 * d0);
                    f32x16 O[4]; float m2, ll;
                    attn_tile<true>(lds + LDS_KS, lds + LDS_VT, qf, qi, r32, hi, O, m2, ll);
                    const int nsel = b < 3 ? b : 3; const size_t pi = ((size_t)h * SEQ + tok) * 3;
                    float M = m2;
#pragma unroll 1
                    for (int t = 0; t < nsel; ++t) M = fmaxf(M, ML[pi + t].x);
                    const float wo = __builtin_amdgcn_exp2f(m2 - M); float den = ll * wo;
#pragma unroll
                    for (int d = 0; d < 4; ++d)
#pragma unroll
                        for (int r = 0; r < 16; ++r) O[d][r] *= wo;
#pragma unroll 1
                    for (int t = 0; t < nsel; ++t) { const f32x2 ml = ML[pi + t]; const float wt = ml.y * __builtin_amdgcn_exp2f(ml.x - M); den += wt; addmul_prow(O, PART + (pi + t) * 128, wt, hi); }
                    store_orow(MIX + (size_t)tok * DM + 128 * h, O, 1.0f / den, hi, true);
                    __syncthreads();
                }
            }
        }
        }
#if MK_COOP
        if (ph + 1 < a.ph_hi) {
            if (ph == a.ph_lo) { grid.sync(); bar = xcd_barrier_post((unsigned*)(a.ws + WS_BAR), bst); }
            else xcd_barrier(bar);
        }
#endif
        if ((MK_DUP & 256) && s_ == 3 && redo_ == 0) { redo_ = 1; ph -= 2; } else if (s_ == 4) redo_ = 0;
    }
}

extern "C" void kernel_launch(void* const* d_in, const int* in_sizes, int n_in, void* d_out, int out_size, void* d_ws, size_t ws_size, hipStream_t stream) {
    static int grid = 0;
    if (grid == 0) {
        if (n_in != 19 || out_size != SEQ * DM || ws_size < WS_END) { fprintf(stderr, "kernel_launch: unexpected shapes (n_in %d, out %d, ws %zu); nothing launched\n", n_in, out_size, ws_size); grid = -1; return; }
        int dev = 0, cus = 0, per_cu = 0;
        if (hipGetDevice(&dev) != hipSuccess || hipDeviceGetAttribute(&cus, hipDeviceAttributeMultiprocessorCount, dev) != hipSuccess) { grid = -1; return; }
        if (hipFuncSetAttribute((const void*)mk_fwd, hipFuncAttributeMaxDynamicSharedMemorySize, LDS_BYTES) != hipSuccess) { fprintf(stderr, "kernel_launch: hipFuncSetAttribute failed\n"); grid = -1; return; }
        if (hipOccupancyMaxActiveBlocksPerMultiprocessor(&per_cu, (const void*)mk_fwd, 512, LDS_BYTES) != hipSuccess || per_cu < 1) { fprintf(stderr, "kernel_launch: occupancy query gave %d\n", per_cu); per_cu = 1; }
        (void)hipGetLastError();
        grid = cus * per_cu;
        fprintf(stderr, "kernel_launch: grid %d (%d CUs x %d)\n", grid, cus, per_cu);
    }
    if (grid < 0) return;
    Args a{};
    for (int i = 0; i < 19; ++i) a.in[i] = d_in[i];
    a.out = (float*)d_out; a.ws = (unsigned char*)d_ws;
    for (int i = 0; i < 64; ++i) a.inv_freq[i] = (float)pow(10000.0, -(double)(2 * i) / 128.0);
#if MK_COOP
    a.ph_lo = 0; a.ph_hi = NPH;
    void* args[] = {&a};
    const hipError_t e = hipLaunchCooperativeKernel((const void*)mk_fwd, dim3(grid), dim3(512), args, LDS_BYTES, stream);
    if (e != hipSuccess) fprintf(stderr, "kernel_launch: cooperative launch failed: %s (grid %d)\n", hipGetErrorString(e), grid);
#else
    for (int ph = 0; ph < NPH; ++ph) { a.ph_lo = ph; a.ph_hi = ph + 1; hipLaunchKernelGGL(mk_fwd, dim3(grid), dim3(512), LDS_BYTES, stream, a); }
#endif
}
```

```cpp
#include <hip/hip_runtime.h>
#include <hip/hip_cooperative_groups.h>
#include <cstdio>
#include <cstdint>
#include <cmath>
namespace cg = cooperative_groups;
namespace pg8 {
#define PG8_LAS __attribute__((address_space(3)))
typedef unsigned short bf16_t;
typedef short bf16x8 __attribute__((ext_vector_type(8)));
typedef float f32x4 __attribute__((ext_vector_type(4)));
typedef unsigned u32x4 __attribute__((ext_vector_type(4)));
constexpr int BM = 256, BK = 64, HALF = 128, HTB = HALF * BK * 2  , STAGE_BYTES = 8 * HTB, NXCD = 8, WGM = 8;

__host__ __device__ __forceinline__ int lds_byte(int r, int c) { const int st = (r >> 4) * 2 + (c >> 5), rr = r & 15, cc = c & 31, ob = rr * 64 + cc * 2; return st * 1024 + (ob ^ (((ob >> 9) & 1) << 5)); }
__host__ __device__ __forceinline__ void stage_rc(int b, int& R, int& C) { const int st = b / 1024, sb = b % 1024, swz = sb ^ (((sb >> 9) & 1) << 5); R = (st >> 1) * 16 + swz / 64; C = (st & 1) * 32 + (swz % 64) / 2; }
__host__ __device__ __forceinline__ int perm32(int rho) { const int n = rho >> 4, i = rho & 15; return 8 * (i >> 2) + 4 * n + (i & 3); }

struct Unit { int pm, pn; };
struct Gemm { const bf16_t* A; const bf16_t* Bt; int M, N, K; };

struct StaticOrder {
    int nM, nN, nwg, G, c;
    __host__ __device__ void init(int M, int N, int G_, int c_) { nM = M / BM; nN = N / BM; nwg = nM * nN; G = G_; c = c_; }
    __host__ __device__ bool next(int i, Unit& u) const {
        const long L = (long)i * G + c; if (L >= nwg) return false;
        int wgid = (int)L; { const int q = nwg / NXCD, r = nwg % NXCD, xcd = wgid % NXCD, off = wgid / NXCD; wgid = (xcd < r ? xcd * (q + 1) : r * (q + 1) + (xcd - r) * q) + off; }
        const int nig = WGM * nN, gid = wgid / nig, fm = gid * WGM, gsz = (nM - fm) < WGM ? (nM - fm) : WGM;
        u.pm = fm + ((wgid % nig) % gsz); u.pn = (wgid % nig) / gsz; return true;
    }
    __device__ __forceinline__ void a_ready(const Unit&) const {}
    __device__ __forceinline__ void done(const Unit&) const {}
};

__device__ __forceinline__ unsigned cvt_pk_bf16(float lo, float hi) { unsigned r; asm volatile("v_cvt_pk_bf16_f32 %0, %1, %2" : "=v"(r) : "v"(lo), "v"(hi)); return r; }
typedef float f32x2 __attribute__((ext_vector_type(2)));
struct EpiF32 {
    static constexpr bool PERM = false, AFTER_DRAIN = false;
    float* C; int ldc;
    __device__ __forceinline__ void operator()(const f32x4 (&acc)[2][2][4][2], const Unit& u, int wr, int wc, int fr, int fq) const {
        const int row0 = u.pm * BM + wr * 64 + fr, col0 = u.pn * BM + wc * 32 + 4 * fq;
#pragma unroll
        for (int ai = 0; ai < 2; ++ai)
#pragma unroll
            for (int m = 0; m < 4; ++m) { float* rowp = C + (size_t)(row0 + ai * HALF + m * 16) * ldc + col0;
#pragma unroll
                for (int bj = 0; bj < 2; ++bj)
#pragma unroll
                    for (int n = 0; n < 2; ++n) *(f32x4*)(rowp + bj * HALF + n * 16) = acc[ai][bj][m][n]; }
    }
};
__device__ __forceinline__ float row_rstd(const float* ssq, int row, int fq) {
    const f32x4* p = (const f32x4*)(ssq + (size_t)row * 32 + fq * 8);
    const f32x4 a = p[0], b = p[1];
    float s = ((a[0] + a[1]) + (a[2] + a[3])) + ((b[0] + b[1]) + (b[2] + b[3]));
    s += __shfl_xor(s, 16); s += __shfl_xor(s, 32);
    return 1.0f / sqrtf(s * (1.0f / 2048.0f) + 1e-6f);
}
__device__ __forceinline__ f32x4 swiglu4(f32x4 g, f32x4 u) {
    f32x4 o;
#pragma unroll
    for (int e = 0; e < 4; ++e) { const float t = __builtin_amdgcn_exp2f(g[e] * -1.4426950408889634f); o[e] = g[e] * __builtin_amdgcn_rcpf(1.0f + t) * u[e]; }
    return o;
}
struct EpiSwiglu {
    static constexpr bool PERM = true, AFTER_DRAIN = false;
    bf16_t* H; const float* ssq; mutable float rs[2][4]; mutable int last_pm;
    __device__ __forceinline__ void operator()(const f32x4 (&acc)[2][2][4][2], const Unit& u, int wr, int wc, int fr, int fq) const {
        const int row0 = u.pm * BM + wr * 64 + fr, col0 = u.pn * HALF + wc * 32 + 8 * fq;
        if (u.pm != last_pm) { last_pm = u.pm;
#pragma unroll
            for (int ai = 0; ai < 2; ++ai)
#pragma unroll
                for (int m = 0; m < 4; ++m) rs[ai][m] = row_rstd(ssq, row0 + ai * HALF + m * 16, fq); }
#pragma unroll
        for (int ai = 0; ai < 2; ++ai)
#pragma unroll
            for (int m = 0; m < 4; ++m) { const int row = row0 + ai * HALF + m * 16; const float r = rs[ai][m];
                const f32x4 h0 = swiglu4(acc[ai][0][m][0] * r, acc[ai][1][m][0] * r), h1 = swiglu4(acc[ai][0][m][1] * r, acc[ai][1][m][1] * r);
                u32x4 w; w.x = cvt_pk_bf16(h0[0], h0[1]); w.y = cvt_pk_bf16(h0[2], h0[3]); w.z = cvt_pk_bf16(h1[0], h1[1]); w.w = cvt_pk_bf16(h1[2], h1[3]);
                *(u32x4*)(H + (size_t)row * 5632 + col0) = w; }
    }
};
struct EpiProj {
    static constexpr bool PERM = true, AFTER_DRAIN = false;
    bf16_t* P; int ldc; const float* ssq; mutable float rs[2][4]; mutable int last_pm;
    __device__ __forceinline__ void operator()(const f32x4 (&acc)[2][2][4][2], const Unit& u, int wr, int wc, int fr, int fq) const {
        const int row0 = u.pm * BM + wr * 64 + fr, col0 = u.pn * BM + wc * 32 + 8 * fq;
        if (u.pm != last_pm) { last_pm = u.pm;
#pragma unroll
            for (int ai = 0; ai < 2; ++ai)
#pragma unroll
                for (int m = 0; m < 4; ++m) rs[ai][m] = row_rstd(ssq, row0 + ai * HALF + m * 16, fq); }
#pragma unroll
        for (int ai = 0; ai < 2; ++ai)
#pragma unroll
            for (int m = 0; m < 4; ++m) { const int row = row0 + ai * HALF + m * 16; const float r = rs[ai][m];
#pragma unroll
                for (int bj = 0; bj < 2; ++bj) { const f32x4 v0 = acc[ai][bj][m][0] * r, v1 = acc[ai][bj][m][1] * r;
                    u32x4 w; w.x = cvt_pk_bf16(v0[0], v0[1]); w.y = cvt_pk_bf16(v0[2], v0[3]); w.z = cvt_pk_bf16(v1[0], v1[1]); w.w = cvt_pk_bf16(v1[2], v1[3]);
                    *(u32x4*)(P + (size_t)row * ldc + col0 + bj * HALF) = w; } }
    }
};
struct EpiResid {
    static constexpr bool PERM = true, AFTER_DRAIN = false;
    float* Xout; bf16_t* XB; float* ssq; float f;
    __device__ __forceinline__ void operator()(const f32x4 (&acc)[2][2][4][2], const Unit& u, int wr, int wc, int fr, int fq) const {
        const int row0 = u.pm * BM + wr * 64 + fr, col0 = u.pn * BM + wc * 32 + 8 * fq;
        u32x4 xb[2][4][2];
#pragma unroll
        for (int ai = 0; ai < 2; ++ai)
#pragma unroll
            for (int m = 0; m < 4; ++m)
#pragma unroll
                for (int bj = 0; bj < 2; ++bj) xb[ai][m][bj] = *(const u32x4*)(XB + (size_t)(row0 + ai * HALF + m * 16) * 2048 + col0 + bj * HALF);
#pragma unroll
        for (int ai = 0; ai < 2; ++ai) {
#pragma unroll
            for (int m = 0; m < 4; ++m) { const int row = row0 + ai * HALF + m * 16; float ss = 0.f;
#pragma unroll
                for (int bj = 0; bj < 2; ++bj) { const size_t off = (size_t)row * 2048 + col0 + bj * HALF; const u32x4 w = xb[ai][m][bj];
                    f32x4 x0 = (f32x4){__uint_as_float(w.x << 16), __uint_as_float(w.x & 0xffff0000u), __uint_as_float(w.y << 16), __uint_as_float(w.y & 0xffff0000u)};
                    f32x4 x1 = (f32x4){__uint_as_float(w.z << 16), __uint_as_float(w.z & 0xffff0000u), __uint_as_float(w.w << 16), __uint_as_float(w.w & 0xffff0000u)};
                    x0 = x0 + acc[ai][bj][m][0] * f; x1 = x1 + acc[ai][bj][m][1] * f;
                    if (Xout) { *(f32x4*)(Xout + off) = x0; *(f32x4*)(Xout + off + 4) = x1; }
                    if (!Xout) { u32x4 o; o.x = cvt_pk_bf16(x0[0], x0[1]); o.y = cvt_pk_bf16(x0[2], x0[3]); o.z = cvt_pk_bf16(x1[0], x1[1]); o.w = cvt_pk_bf16(x1[2], x1[3]);
                        *(u32x4*)(XB + off) = o; }
                    ss += ((x0[0] * x0[0] + x0[1] * x0[1]) + (x0[2] * x0[2] + x0[3] * x0[3])) + ((x1[0] * x1[0] + x1[1] * x1[1]) + (x1[2] * x1[2] + x1[3] * x1[3])); }
                ss += __shfl_xor(ss, 16); ss += __shfl_xor(ss, 32);
                if (fq == 0 && !Xout) ssq[(size_t)row * 32 + u.pn * 4 + wc] = ss; }
        }
    }
};
struct MkvOrder {
    int c;
    __device__ __forceinline__ bool next(int i, Unit& u) const { if (i != 0 || c >= 8) return false; u.pm = c >> 2; u.pn = c; return true; }
    __device__ __forceinline__ void a_ready(const Unit&) const {}
    __device__ __forceinline__ void done(const Unit&) const {}
};
template <class Epi, class Sched, bool ALIGN_EPI = false, bool SP2 = false>
__device__ __forceinline__ void gemm_phase(PG8_LAS unsigned char* lds, const Gemm g, const Sched& S, const Epi& E) {
    int tid_ = threadIdx.x; asm volatile("" : "+v"(tid_));
    const int tid = tid_, wid = __builtin_amdgcn_readfirstlane(tid >> 6), lane = tid & 63, wr = wid >> 2, wc = wid & 3, fr = lane & 15, fq = lane >> 4;
    const int K = g.K, nt = K / BK;
    unsigned voffA[2], voffB[2];
#pragma unroll
    for (int i = 0; i < 2; ++i) { int R, C; stage_rc(tid * 16 + i * 8192, R, C); const int Rb = Epi::PERM ? ((R & ~31) + perm32(R & 31)) : R;
        voffA[i] = (unsigned)(R * K + C) * 2u; voffB[i] = (unsigned)(Rb * K + C) * 2u; }
    const size_t kstep = (size_t)(BK * 2);
    const size_t hstep = (size_t)HALF * K * 2;
    const size_t tstep = 2 * hstep;
    const unsigned ldsw = (unsigned)wid * 1024u;
    const int aoff = lds_byte(wr * 64 + fr, fq * 8), boff = lds_byte(wc * 32 + fr, fq * 8);
#define PG8_SA(b, h) (((b) * 2 + (h)) * HTB)
#define PG8_SB(b, h) ((4 + (b) * 2 + (h)) * HTB)
#define PG8_STAGE(bufoff, gbase, voff) do { _Pragma("unroll") for (int _i = 0; _i < 2; ++_i) \
        __builtin_amdgcn_global_load_lds((const unsigned*)((const char*)(gbase) + (voff)[_i]), (PG8_LAS unsigned*)(lds + (bufoff) + ldsw + _i * 8192), 16, 0, 0); } while (0)
#define PG8_LDA(dst, b, h) do { _Pragma("unroll") for (int m = 0; m < 4; ++m) _Pragma("unroll") for (int k = 0; k < 2; ++k) dst[m][k] = *(const PG8_LAS bf16x8*)(lds + PG8_SA(b, h) + aoff + m * 2048 + k * 1024); } while (0)
#define PG8_LDB(dst, b, h) do { _Pragma("unroll") for (int n = 0; n < 2; ++n) _Pragma("unroll") for (int k = 0; k < 2; ++k) dst[n][k] = *(const PG8_LAS bf16x8*)(lds + PG8_SB(b, h) + boff + n * 2048 + k * 1024); } while (0)
#define PG8_MMA(ai, bj, At, Bt) do { __builtin_amdgcn_s_setprio(1); _Pragma("unroll") for (int m = 0; m < 4; ++m) _Pragma("unroll") for (int n = 0; n < 2; ++n) _Pragma("unroll") for (int k = 0; k < 2; ++k) \
        acc[ai][bj][m][n] = __builtin_amdgcn_mfma_f32_16x16x32_bf16(Bt[n][k], At[m][k], acc[ai][bj][m][n], 0, 0, 0); __builtin_amdgcn_s_setprio(0); } while (0)
#define PG8_WAIT_V(n) asm volatile("s_waitcnt vmcnt(" #n ")" ::: "memory")
#define PG8_WAIT_L(n) asm volatile("s_waitcnt lgkmcnt(" #n ")" ::: "memory")
#define PG8_BAR __builtin_amdgcn_s_barrier()
#define PG8_SCHED __builtin_amdgcn_sched_barrier(0)
    Unit cur, nxt; int ui = 0;
    if (!S.next(0, cur)) return;
    f32x4 acc[2][2][4][2];
#pragma unroll
    for (int a = 0; a < 2; ++a)
#pragma unroll
        for (int b = 0; b < 2; ++b)
#pragma unroll
            for (int m = 0; m < 4; ++m)
#pragma unroll
                for (int n = 0; n < 2; ++n) acc[a][b][m][n] = (f32x4){0.f, 0.f, 0.f, 0.f};
    bf16x8 At[4][2], B0[2][2], B1[2][2];
    const char* cA = (const char*)g.A + (size_t)cur.pm * tstep; const char* cB = (const char*)g.Bt + (size_t)cur.pn * tstep;
    S.a_ready(cur);
    if constexpr (SP2) {
        PG8_STAGE(PG8_SB(0, 0), cB, voffB); PG8_STAGE(PG8_SB(0, 1), cB + hstep, voffB); PG8_STAGE(PG8_SA(0, 0), cA, voffA); PG8_STAGE(PG8_SA(0, 1), cA + hstep, voffA);
        if (wr == 1) PG8_BAR;
        PG8_WAIT_V(2); PG8_BAR;
        PG8_STAGE(PG8_SB(1, 0), cB + kstep, voffB); PG8_STAGE(PG8_SA(1, 0), cA + kstep, voffA); PG8_STAGE(PG8_SB(1, 1), cB + hstep + kstep, voffB);
        PG8_WAIT_V(6); PG8_BAR;
    } else {
        PG8_STAGE(PG8_SB(0, 0), cB, voffB); PG8_STAGE(PG8_SA(0, 0), cA, voffA); PG8_STAGE(PG8_SB(0, 1), cB + hstep, voffB); PG8_STAGE(PG8_SA(0, 1), cA + hstep, voffA);
        if (wr == 1) PG8_BAR;
        PG8_WAIT_V(4); PG8_BAR;
        PG8_STAGE(PG8_SB(1, 0), cB + kstep, voffB); PG8_STAGE(PG8_SA(1, 0), cA + kstep, voffA); PG8_STAGE(PG8_SB(1, 1), cB + hstep + kstep, voffB);
        PG8_WAIT_V(6); PG8_BAR;
    }
    for (;;) {
        const bool has_next = S.next(ui + 1, nxt);
        const char* nA = has_next ? (const char*)g.A + (size_t)nxt.pm * tstep : cA; const char* nB = has_next ? (const char*)g.Bt + (size_t)nxt.pn * tstep : cB;
        for (int t = 0; t < nt; t += 2) {
            const bool last = (t == nt - 2);
            const char* a1 = cA + (size_t)(t + 1) * kstep;
            const char* a2 = last ? nA : cA + (size_t)(t + 2) * kstep; const char* b2 = last ? nB : cB + (size_t)(t + 2) * kstep;
            const char* a3 = a2 + kstep; const char* b3 = b2 + kstep;
            if (last && has_next) S.a_ready(nxt);
            if constexpr (SP2) {
            PG8_LDB(B0, 0, 0); PG8_LDB(B1, 0, 1); PG8_SCHED; PG8_LDA(At, 0, 0); PG8_STAGE(PG8_SA(1, 1), a1 + hstep, voffA);
            PG8_WAIT_V(8); PG8_WAIT_L(0); PG8_BAR; PG8_MMA(0, 0, At, B0); PG8_MMA(0, 1, At, B1); PG8_BAR; PG8_SCHED;
            PG8_LDA(At, 0, 1); PG8_STAGE(PG8_SB(0, 0), b2, voffB); PG8_STAGE(PG8_SB(0, 1), b2 + hstep, voffB); PG8_STAGE(PG8_SA(0, 0), a2, voffA);
            PG8_WAIT_V(8); PG8_WAIT_L(0); PG8_BAR; PG8_MMA(1, 0, At, B0); PG8_MMA(1, 1, At, B1); PG8_BAR; PG8_SCHED;
            PG8_LDB(B0, 1, 0); PG8_LDB(B1, 1, 1); PG8_SCHED; PG8_LDA(At, 1, 0); PG8_STAGE(PG8_SA(0, 1), a2 + hstep, voffA);
            PG8_WAIT_V(8); PG8_WAIT_L(0); PG8_BAR; PG8_MMA(0, 0, At, B0); PG8_MMA(0, 1, At, B1); PG8_BAR; PG8_SCHED;
            PG8_LDA(At, 1, 1); PG8_STAGE(PG8_SB(1, 0), b3, voffB); PG8_STAGE(PG8_SB(1, 1), b3 + hstep, voffB); PG8_STAGE(PG8_SA(1, 0), a3, voffA);
            PG8_WAIT_V(8); PG8_WAIT_L(0); PG8_BAR; PG8_MMA(1, 0, At, B0); PG8_MMA(1, 1, At, B1); PG8_BAR; PG8_SCHED;
            } else {
            PG8_LDB(B0, 0, 0); PG8_SCHED; PG8_LDA(At, 0, 0); PG8_STAGE(PG8_SA(1, 1), a1 + hstep, voffA);
            PG8_WAIT_L(8); PG8_BAR; PG8_WAIT_L(0); PG8_MMA(0, 0, At, B0); PG8_BAR; PG8_SCHED;
            PG8_LDB(B1, 0, 1); PG8_STAGE(PG8_SB(0, 0), b2, voffB);
            PG8_BAR; PG8_WAIT_L(0); PG8_MMA(0, 1, At, B1); PG8_BAR;
            PG8_LDA(At, 0, 1); PG8_STAGE(PG8_SA(0, 0), a2, voffA);
            PG8_BAR; PG8_WAIT_L(0); PG8_MMA(1, 0, At, B0); PG8_BAR; PG8_SCHED;
            PG8_STAGE(PG8_SB(0, 1), b2 + hstep, voffB);
            PG8_WAIT_V(6); PG8_BAR; PG8_MMA(1, 1, At, B1); PG8_BAR;
            PG8_LDB(B0, 1, 0); PG8_SCHED; PG8_LDA(At, 1, 0); PG8_STAGE(PG8_SA(0, 1), a2 + hstep, voffA);
            PG8_WAIT_L(8); PG8_BAR; PG8_WAIT_L(0); PG8_MMA(0, 0, At, B0); PG8_BAR; PG8_SCHED;
            PG8_LDB(B1, 1, 1); PG8_STAGE(PG8_SB(1, 0), b3, voffB);
            PG8_BAR; PG8_WAIT_L(0); PG8_MMA(0, 1, At, B1); PG8_BAR;
            PG8_LDA(At, 1, 1); PG8_STAGE(PG8_SA(1, 0), a3, voffA);
            PG8_BAR; PG8_WAIT_L(0); PG8_MMA(1, 0, At, B0); PG8_BAR; PG8_SCHED;
            PG8_STAGE(PG8_SB(1, 1), b3 + hstep, voffB);
            PG8_WAIT_V(6); PG8_BAR; PG8_MMA(1, 1, At, B1); PG8_BAR;
            }
        }
        if constexpr (ALIGN_EPI) { if (wr == 0) PG8_BAR; }
        if constexpr (!Epi::AFTER_DRAIN) { E(acc, cur, wr, wc, fr, fq); S.done(cur); }
        if (!has_next) break;
#pragma unroll
        for (int a = 0; a < 2; ++a)
#pragma unroll
            for (int b = 0; b < 2; ++b)
#pragma unroll
                for (int m = 0; m < 4; ++m)
#pragma unroll
                    for (int n = 0; n < 2; ++n) acc[a][b][m][n] = (f32x4){0.f, 0.f, 0.f, 0.f};
        cur = nxt; cA = nA; cB = nB; ++ui;
        if constexpr (ALIGN_EPI) { if (wr == 1) PG8_BAR; }
    }
    PG8_WAIT_V(0);
    if constexpr (!ALIGN_EPI) { if (wr == 0) PG8_BAR; }
    PG8_BAR;
    if constexpr (Epi::AFTER_DRAIN) { E.fused(acc, cur, wr, wc, fr, fq, lds, wid, lane); S.done(cur); }
#undef PG8_SA
#undef PG8_SB
#undef PG8_STAGE
#undef PG8_LDA
#undef PG8_LDB
#undef PG8_MMA
#undef PG8_WAIT_V
#undef PG8_WAIT_L
#undef PG8_BAR
#undef PG8_SCHED
}
}

#define LAS __attribute__((address_space(3)))
typedef unsigned short bf16_t;
typedef short bf16x8 __attribute__((ext_vector_type(8)));
typedef short s16x4 __attribute__((ext_vector_type(4)));
typedef float f32x4 __attribute__((ext_vector_type(4)));
typedef float f32x2 __attribute__((ext_vector_type(2)));
typedef float f32x16 __attribute__((ext_vector_type(16)));
typedef unsigned u32x4 __attribute__((ext_vector_type(4)));
typedef unsigned u32x2 __attribute__((ext_vector_type(2)));
typedef __bf16 bf16x2_t __attribute__((ext_vector_type(2)));

constexpr int SEQ = 16384, DM = 2048, DFF = 5632, INW = 5120, NH = 8, HD = 128, NBLK = 64, BLKSZ = 256;
#ifndef EN_MASK
#define EN_MASK 0x1ff
#endif
constexpr bool EN_P0 = EN_MASK & 1, EN_P1 = EN_MASK & 2, EN_GU = EN_MASK & 4, EN_RES = EN_MASK & 8, EN_PROJ = EN_MASK & 16, EN_PRE = EN_MASK & 32, EN_GATE = EN_MASK & 64, EN_SEL = EN_MASK & 128, EN_OWN = EN_MASK & 256;
#ifndef MK_DUP
#define MK_DUP 0
#endif
constexpr int NPH = 22;
#ifndef MK_COOP
#define MK_COOP 1
#endif
constexpr size_t MiB = 1u << 20;
constexpr size_t WS_CNT = 0;
constexpr size_t WS_BAR = 16 * 1024;
constexpr size_t WS_KMEAN = 64 * 1024;
constexpr size_t WS_SSQ = 1 * MiB;
constexpr size_t WS_ROPE = 4 * MiB;
constexpr size_t WS_MEMB = 12 * MiB;
constexpr size_t WS_MKV = 14 * MiB;
constexpr size_t WS_ML = 18 * MiB;
constexpr size_t WS_WT = 22 * MiB;
constexpr size_t WT_LAYER = 160 * MiB, WT_GU1 = 0, WT_D1 = 44 * MiB, WT_IN = 66 * MiB, WT_OUT = 86 * MiB, WT_GU2 = 94 * MiB, WT_D2 = 138 * MiB;
constexpr size_t WS_XB = 350 * MiB;
constexpr size_t WS_LIST = WS_XB, WS_VT = WS_XB + 32 * MiB;
constexpr size_t WS_H = 414 * MiB;
constexpr size_t WS_MIX = 590 * MiB;
constexpr size_t WS_PART = 654 * MiB;
constexpr size_t WS_END = 750 * MiB;
constexpr int LDS_BYTES = 147456;
constexpr int KS_STRIDE = 272, VT_STRIDE = 528, LDS_KS = 0, LDS_VT = 256 * KS_STRIDE, LDS_MISC = 139264;
static_assert(LDS_VT + 128 * VT_STRIDE <= LDS_MISC, "lds map");

#define TID_LOCALS int tid_ = threadIdx.x; asm volatile("" : "+v"(tid_)); const int tid = tid_, lane = tid & 63, wave = __builtin_amdgcn_readfirstlane(tid >> 6), r32 = lane & 31, hi = lane >> 5; (void)r32; (void)hi; (void)wave; (void)lane;
struct Args { const void* in[19]; float* out; unsigned char* ws; float inv_freq[64]; int ph_lo, ph_hi; };

__device__ __forceinline__ unsigned cvtpk(float lo, float hi) { f32x2 v = {lo, hi}; bf16x2_t b = __builtin_convertvector(v, bf16x2_t); return __builtin_bit_cast(unsigned, b); }
__device__ __forceinline__ float bflo(unsigned w) { return __uint_as_float(w << 16); }
__device__ __forceinline__ float bfhi(unsigned w) { return __uint_as_float(w & 0xffff0000u); }
__device__ __forceinline__ float wave_sum(float v) {
#pragma unroll
    for (int o = 1; o < 64; o <<= 1) v += __shfl_xor(v, o);
    return v;
}
__device__ __forceinline__ int crow(int r, int hi) { return (r & 3) + 8 * (r >> 2) + 4 * hi; }
#define MFMA32(a, b, c) __builtin_amdgcn_mfma_f32_32x32x16_bf16((a), (b), (c), 0, 0, 0)

__device__ __forceinline__ void tr_item(const float* W, int K, int N, bf16_t* WT, const float* gain, int perm, LAS float* scr, int item, int lane) {
    const int nblk = N / 64, kb = item / nblk, nb = item % nblk, k0 = 64 * kb, n0 = 64 * nb, lr = lane >> 4, c4 = lane & 15;
    f32x4 v[16];
#pragma unroll
    for (int i = 0; i < 16; ++i) v[i] = *(const f32x4*)(W + (size_t)(k0 + lr + 4 * i) * N + n0 + 4 * c4);
    if (gain) {
#pragma unroll
        for (int i = 0; i < 16; ++i) v[i] = v[i] * gain[k0 + lr + 4 * i];
    }
#pragma unroll
    for (int i = 0; i < 16; ++i)
#pragma unroll
        for (int e = 0; e < 4; ++e) scr[(lr + 4 * i) * 65 + 4 * c4 + e] = v[i][e];
    asm volatile("s_waitcnt lgkmcnt(0)" ::: "memory");
    const int c = lane & 7;
#pragma unroll
    for (int j = 0; j < 8; ++j) { const int n = (lane >> 3) + 8 * j; const LAS float* s = scr + (8 * c) * 65 + n;
        u32x4 o; o.x = cvtpk(s[0 * 65], s[1 * 65]); o.y = cvtpk(s[2 * 65], s[3 * 65]); o.z = cvtpk(s[4 * 65], s[5 * 65]); o.w = cvtpk(s[6 * 65], s[7 * 65]);
        const int ncol = n0 + n; int drow = ncol;
        if (perm) { const int hf = ncol >= DFF ? 1 : 0, jj = ncol - hf * DFF; drow = 256 * (jj >> 7) + 128 * hf + (jj & 127); }
        *(u32x4*)(WT + (size_t)drow * K + k0 + 8 * c) = o; }
    asm volatile("s_waitcnt lgkmcnt(0)" ::: "memory");
}

template <bool CAUSAL>
__device__ __forceinline__ void attn_tile(const LAS unsigned char* Ks, const LAS unsigned char* Vts, const bf16x8 (&qf)[8], int qi, int r32, int hi, f32x16 (&O)[4], float& m2, float& l) {
    const float c = 0.08838834764831845f * 1.4426950408889634f;
    float m = -1.0e30f, lsum = 0.f;
#pragma unroll
    for (int d = 0; d < 4; ++d)
#pragma unroll
        for (int r = 0; r < 16; ++r) O[d][r] = 0.f;
#pragma unroll 1
    for (int hf = 0; hf < 2; ++hf) {
        f32x16 S[4];
#pragma unroll
        for (int s = 0; s < 4; ++s) {
            f32x16 a;
#pragma unroll
            for (int r = 0; r < 16; ++r) a[r] = 0.f;
            const LAS unsigned char* kp = Ks + (128 * hf + 32 * s + r32) * KS_STRIDE + 16 * hi;
#pragma unroll
            for (int d0 = 0; d0 < 8; ++d0) { const bf16x8 kf = *(const LAS bf16x8*)(kp + 32 * d0); a = MFMA32(kf, qf[d0], a); }
            S[s] = a;
            __builtin_amdgcn_sched_barrier(0);
        }
        float mx = -1.0e30f;
#pragma unroll
        for (int s = 0; s < 4; ++s)
#pragma unroll
            for (int r = 0; r < 16; ++r) { float v = S[s][r]; if (CAUSAL) { if (128 * hf + 32 * s + crow(r, hi) > qi) v = -INFINITY; S[s][r] = v; } mx = fmaxf(mx, v); }
        mx = fmaxf(mx, __shfl_xor(mx, 32));
        const float mn = fmaxf(m, mx * c), alpha = __builtin_amdgcn_exp2f(m - mn);
        m = mn; lsum *= alpha;
#pragma unroll
        for (int d = 0; d < 4; ++d)
#pragma unroll
            for (int r = 0; r < 16; ++r) O[d][r] *= alpha;
#pragma unroll
        for (int s = 0; s < 4; ++s)
#pragma unroll
            for (int r = 0; r < 16; ++r) { const float p = __builtin_amdgcn_exp2f(S[s][r] * c - mn); S[s][r] = p; lsum += p; }
#pragma unroll
        for (int s = 0; s < 4; ++s)
#pragma unroll
            for (int j = 0; j < 2; ++j) {
                u32x4 pw; pw.x = cvtpk(S[s][8 * j + 0], S[s][8 * j + 1]); pw.y = cvtpk(S[s][8 * j + 2], S[s][8 * j + 3]); pw.z = cvtpk(S[s][8 * j + 4], S[s][8 * j + 5]); pw.w = cvtpk(S[s][8 * j + 6], S[s][8 * j + 7]);
                const bf16x8 pf = __builtin_bit_cast(bf16x8, pw);
#pragma unroll
                for (int d = 0; d < 4; ++d) {
                    const LAS unsigned char* vp = Vts + (32 * d + r32) * VT_STRIDE + (128 * hf + 32 * s + 16 * j + 4 * hi) * 2;
                    const s16x4 lo = *(const LAS s16x4*)vp, h4 = *(const LAS s16x4*)(vp + 16);
                    const bf16x8 vf = __builtin_shufflevector(lo, h4, 0, 1, 2, 3, 4, 5, 6, 7);
                    O[d] = MFMA32(vf, pf, O[d]);
                }
                __builtin_amdgcn_sched_barrier(0);
            }
    }
    lsum += __shfl_xor(lsum, 32);
    m2 = m; l = lsum;
}
__device__ __forceinline__ void stage_kv(LAS unsigned char* lds, const bf16_t* Kg, int kpitch, const bf16_t* Vtg, int tid) {
#pragma unroll
    for (int i = 0; i < 8; ++i) { const int c = tid + 512 * i, row = c >> 4, ch = c & 15; *(LAS u32x4*)(lds + LDS_KS + row * KS_STRIDE + ch * 16) = *(const u32x4*)(Kg + (size_t)row * kpitch + ch * 8); }
#pragma unroll
    for (int i = 0; i < 8; ++i) { const int c = tid + 512 * i, row = c >> 5, ch = c & 31; *(LAS u32x4*)(lds + LDS_VT + row * VT_STRIDE + ch * 16) = *(const u32x4*)(Vtg + (size_t)row * 256 + ch * 8); }
}
__device__ __forceinline__ void store_orow(bf16_t* orow, const f32x16 (&O)[4], float sc, int hi, bool st) {
#pragma unroll
    for (int d = 0; d < 4; ++d)
#pragma unroll
        for (int k = 0; k < 2; ++k) {
            const unsigned x0 = cvtpk(O[d][8 * k + 0] * sc, O[d][8 * k + 1] * sc), x1 = cvtpk(O[d][8 * k + 2] * sc, O[d][8 * k + 3] * sc);
            const unsigned y0 = cvtpk(O[d][8 * k + 4] * sc, O[d][8 * k + 5] * sc), y1 = cvtpk(O[d][8 * k + 6] * sc, O[d][8 * k + 7] * sc);
            const auto r0 = __builtin_amdgcn_permlane32_swap(x0, y0, false, false), r1 = __builtin_amdgcn_permlane32_swap(x1, y1, false, false);
            u32x4 w; w.x = r0[0]; w.y = r1[0]; w.z = r0[1]; w.w = r1[1];
            if (st) *(u32x4*)(orow + 32 * d + 16 * k + 8 * hi) = w;
        }
}
__device__ __forceinline__ void addmul_prow(f32x16 (&O)[4], const bf16_t* pr, float wt, int hi) {
#pragma unroll
    for (int d = 0; d < 4; ++d)
#pragma unroll
        for (int k = 0; k < 2; ++k) {
            const u32x4 w = *(const u32x4*)(pr + 32 * d + 16 * k + 8 * hi);
            const auto r0 = __builtin_amdgcn_permlane32_swap(w.x, w.z, false, false), r1 = __builtin_amdgcn_permlane32_swap(w.y, w.w, false, false);
            O[d][8 * k + 0] += wt * bflo(r0[0]); O[d][8 * k + 1] += wt * bfhi(r0[0]); O[d][8 * k + 2] += wt * bflo(r1[0]); O[d][8 * k + 3] += wt * bfhi(r1[0]);
            O[d][8 * k + 4] += wt * bflo(r0[1]); O[d][8 * k + 5] += wt * bfhi(r0[1]); O[d][8 * k + 6] += wt * bflo(r1[1]); O[d][8 * k + 7] += wt * bfhi(r1[1]);
        }
}

__device__ __forceinline__ void norm_rope_block(const u32x4 (&a)[4], const u32x4 (&c)[4]  , bf16_t* obase, int opitch, const float* gain, const int* positions, const f32x4 (&rp)[16]  , int tok0, bool do_mean, float* kmean, LAS unsigned char* lds, int tid) {
    const int row = tid >> 1, hf = tid & 1, tok = tok0 + row, lane = tid & 63, wave = tid >> 6;
    float x1[32], x2[32]; float ss = 0.f;
#pragma unroll
    for (int i = 0; i < 4; ++i)
#pragma unroll
        for (int e = 0; e < 4; ++e) { x1[8 * i + 2 * e] = bflo(a[i][e]); x1[8 * i + 2 * e + 1] = bfhi(a[i][e]); x2[8 * i + 2 * e] = bflo(c[i][e]); x2[8 * i + 2 * e + 1] = bfhi(c[i][e]); }
#pragma unroll
    for (int i = 0; i < 32; ++i) ss += x1[i] * x1[i] + x2[i] * x2[i];
    ss += __shfl_xor(ss, 1);
    const float rstd = 1.0f / sqrtf(ss * (1.0f / 128.0f) + 1e-6f);
#pragma unroll
    for (int i = 0; i < 32; ++i) { const float n1 = x1[i] * rstd * gain[32 * hf + i], n2 = x2[i] * rstd * gain[64 + 32 * hf + i]; const float cs_x = rp[i >> 1][2 * (i & 1)], cs_y = rp[i >> 1][2 * (i & 1) + 1];
        x1[i] = n1 * cs_x - n2 * cs_y; x2[i] = n2 * cs_x + n1 * cs_y; }
#pragma unroll
    for (int i = 0; i < 4; ++i) { u32x4 w, v;
#pragma unroll
        for (int e = 0; e < 4; ++e) { w[e] = cvtpk(x1[8 * i + 2 * e], x1[8 * i + 2 * e + 1]); v[e] = cvtpk(x2[8 * i + 2 * e], x2[8 * i + 2 * e + 1]); }
        bf16_t* po = obase + (size_t)row * opitch; *(u32x4*)(po + 32 * hf + 8 * i) = w; *(u32x4*)(po + 64 + 32 * hf + 8 * i) = v; }
    if (do_mean) {
        LAS float* tile = (LAS float*)lds;
#pragma unroll
        for (int i = 0; i < 8; ++i) { *(LAS f32x4*)(tile + row * 132 + 32 * hf + 4 * i) = (f32x4){x1[4 * i], x1[4 * i + 1], x1[4 * i + 2], x1[4 * i + 3]};
                                      *(LAS f32x4*)(tile + row * 132 + 64 + 32 * hf + 4 * i) = (f32x4){x2[4 * i], x2[4 * i + 1], x2[4 * i + 2], x2[4 * i + 3]}; }
        __syncthreads();
        { const int d = tid & 127, q4 = tid >> 7; float sacc = 0.f;
#pragma unroll 16
          for (int r = 0; r < 64; ++r) sacc += tile[(64 * q4 + r) * 132 + d];
          LAS float* part = (LAS float*)(lds + LDS_MISC);
          part[q4 * 128 + d] = sacc; }
        __syncthreads();
        if (tid < 128) { LAS float* part = (LAS float*)(lds + LDS_MISC); kmean[tid] = ((part[tid] + part[128 + tid]) + (part[256 + tid] + part[384 + tid])) * (1.0f / 256.0f); }
        __syncthreads();
    }
}

#define XB_TMO      128
#define XB_XCNT(j)  (256  + 64 * (j))
#define XB_XSUB(j)  (1280 + 64 * (j))
#define XB_XGEN(j)  (2304 + 64 * (j))
#define XB_TOP      3328
#define XB_TOPGEN   3392
#define XCD_BAR_WORDS 3456
#define XB_SPIN_CAP (1u << 18)

__device__ __forceinline__ unsigned xb_ld(unsigned* p)              { return __hip_atomic_load(p, __ATOMIC_RELAXED, __HIP_MEMORY_SCOPE_AGENT); }
__device__ __forceinline__ unsigned xb_add(unsigned* p, unsigned v) { return __hip_atomic_fetch_add(p, v, __ATOMIC_RELAXED, __HIP_MEMORY_SCOPE_AGENT); }
__device__ __forceinline__ unsigned xb_xcc_id() { return (unsigned)__builtin_amdgcn_s_getreg((3 << 11) | 20) & 0xFu; }
#define XB_SPIN(cond, bar) do { unsigned _sp = 0; while (cond) { __builtin_amdgcn_s_sleep(1); \
    if ((++_sp & 255u) == 0u) { if (xb_ld(&(bar)[XB_TMO])) break; if (_sp > XB_SPIN_CAP) { atomicAdd(&(bar)[XB_TMO], 1u); break; } } } } while (0)

struct XcdBarrier {
    unsigned* bar; unsigned x;
    volatile LAS unsigned* st;
};

__device__ __forceinline__ XcdBarrier xcd_barrier_post(unsigned* bar, volatile LAS unsigned* st) {
    XcdBarrier b; b.bar = bar; b.x = xb_xcc_id(); b.st = st;
    if (threadIdx.x == 0) (void)xb_add(&bar[XB_XCNT(b.x)], 1u);
    return b;
}
__device__ __forceinline__ void xcd_barrier_complete(unsigned* bar, unsigned x, unsigned& nloc, unsigned& nx) {
    const unsigned G = gridDim.x * gridDim.y * gridDim.z;
    unsigned sum, cnt, mine, sp = 0u;
    for (;;) {
        sum = 0u; cnt = 0u; mine = 0u;
#pragma unroll
        for (unsigned j = 0; j < 16; ++j) { const unsigned c = xb_ld(&bar[XB_XCNT(j)]); sum += c; cnt += (c > 0u) ? 1u : 0u; mine = (j == x) ? c : mine; }
        if (sum == G) break;
        __builtin_amdgcn_s_sleep(1);
        if ((++sp & 255u) == 0u) { if (xb_ld(&bar[XB_TMO])) break; if (sp > XB_SPIN_CAP) { atomicAdd(&bar[XB_TMO], 1u); break; } }
    }
    nloc = mine > 0u ? mine : 1u; nx = cnt > 0u ? cnt : 1u;
}

__device__ __forceinline__ void xcd_barrier(const XcdBarrier& b) {
    asm volatile("s_waitcnt vmcnt(0)" ::: "memory");
    __syncthreads();
    if (threadIdx.x == 0) {
        unsigned* bar = b.bar;
        __builtin_amdgcn_s_waitcnt(0);
        unsigned nloc = b.st[0], nx = b.st[1];
        if (nloc == 0u) { xcd_barrier_complete(bar, b.x, nloc, nx); b.st[0] = nloc; b.st[1] = nx; }
        const unsigned old = xb_add(&bar[XB_XSUB(b.x)], 1u);
        const unsigned gen = old / nloc;
        if (old + 1u == (gen + 1u) * nloc) {
            __builtin_amdgcn_fence(__ATOMIC_RELEASE, "agent");
            asm volatile("s_waitcnt vmcnt(0)" ::: "memory");
            const unsigned og = xb_add(&bar[XB_TOP], 1u);
            const unsigned tg = og / nx;
            if (og + 1u == (tg + 1u) * nx) xb_add(&bar[XB_TOPGEN], 1u);
            else XB_SPIN(xb_ld(&bar[XB_TOPGEN]) == tg, bar);
            __builtin_amdgcn_fence(__ATOMIC_ACQUIRE, "agent");
            xb_add(&bar[XB_XGEN(b.x)], 1u);
            asm volatile("s_waitcnt vmcnt(0)" ::: "memory");
        } else {
            XB_SPIN(xb_ld(&bar[XB_XGEN(b.x)]) == gen, bar);
            __builtin_amdgcn_fence(__ATOMIC_ACQUIRE, "agent");
            asm volatile("s_waitcnt vmcnt(0)" ::: "memory");
        }
    }
    __syncthreads();
}

__global__ void __launch_bounds__(512, 2) mk_fwd(Args a) {
    extern __shared__ __attribute__((aligned(16))) unsigned char lds_raw[];
    LAS unsigned char* lds = (LAS unsigned char*)lds_raw;
    cg::grid_group grid = cg::this_grid();
    volatile LAS unsigned* bst = (volatile LAS unsigned*)(lds + LDS_BYTES - 16);
    if (threadIdx.x < 2) bst[threadIdx.x] = 0u;
    __syncthreads();
    XcdBarrier bar; bar.bar = nullptr; bar.x = 0; bar.st = bst;
    int redo_ = 0;
    for (int ph = a.ph_lo; ph < a.ph_hi; ++ph) {
        int bid_ = blockIdx.x, G_ = gridDim.x; asm volatile("" : "+s"(bid_), "+s"(G_));
        const int G = G_, bid = bid_;
        unsigned char* ws = a.ws; asm volatile("" : "+s"(ws));
        const float* x_in = (const float*)a.in[0]; const float* mem = (const float*)a.in[1]; const int* positions = (const int*)a.in[2];
        float* X = a.out;
        unsigned* CNT = (unsigned*)(ws + WS_CNT); float* KMEAN = (float*)(ws + WS_KMEAN); float* SSQ = (float*)(ws + WS_SSQ); f32x2* ROPE = (f32x2*)(ws + WS_ROPE);
        bf16_t* MEMB = (bf16_t*)(ws + WS_MEMB); float* MKV = (float*)(ws + WS_MKV); f32x2* ML = (f32x2*)(ws + WS_ML);
        bf16_t* XB = (bf16_t*)(ws + WS_XB); unsigned* LIST = (unsigned*)a.out; bf16_t* VT = (bf16_t*)((unsigned char*)a.out + 32 * MiB);
        bf16_t* H = (bf16_t*)(ws + WS_H); bf16_t* PROJ = (bf16_t*)(ws + WS_H); bf16_t* MIX = (bf16_t*)(ws + WS_MIX); bf16_t* PART = (bf16_t*)(ws + WS_PART);
        bf16_t* WT_MKV = (bf16_t*)(ws + WS_WT);

        const int s_ = ph >= 2 ? (ph - 2) % 10 : -1;
        const int nrep = (((MK_DUP & 1) && ph == 0) || ((MK_DUP & 2) && (s_ == 5 || s_ == 6)) || ((MK_DUP & 4) && (s_ == 0 || s_ == 8)) || ((MK_DUP & 8) && s_ == 2) || ((MK_DUP & 16) && ph == 1) || ((MK_DUP & 32) && ph == 3) || ((MK_DUP & 64) && (s_ == 1 || s_ == 7 || s_ == 9)) || ((MK_DUP & 128) && s_ == 3)) ? 2 : 1;
        for (int rep = 0; rep < nrep; ++rep) {
        if (rep) __syncthreads();
        if (EN_P0 && ph == 0) {
            TID_LOCALS
            LAS float* scr = (LAS float*)(lds + wave * 16640);
            const int gw = bid * 8 + wave, NGW = G * 8;
            constexpr int I_MKV = 32 * 16;
            for (int it = gw; it < 2 * I_MKV; it += NGW) { const int l = it >= I_MKV ? 1 : 0, r = it - l * I_MKV;
                tr_item((const float*)a.in[12] + (size_t)l * DM * 1024, DM, 1024, WT_MKV + (size_t)l * 1024 * DM, nullptr, 0, scr, r, lane); }
            for (int mr = gw; mr < 512; mr += NGW) {
                const int ml = mr >> 8;
                const f32x4* xr = (const f32x4*)(mem + (size_t)(mr & 255) * DM) + lane;
                f32x4 v[8]; float ss = 0.f;
#pragma unroll
                for (int j = 0; j < 8; ++j) { v[j] = xr[64 * j]; ss += (v[j][0] * v[j][0] + v[j][1] * v[j][1]) + (v[j][2] * v[j][2] + v[j][3] * v[j][3]); }
                ss = wave_sum(ss);
                const float rstd = 1.0f / sqrtf(ss * (1.0f / DM) + 1e-6f); const f32x4* gn = (const f32x4*)((const float*)a.in[11] + ml * DM) + lane;
                u32x2* o = (u32x2*)(MEMB + (size_t)mr * DM) + lane;
#pragma unroll
                for (int j = 0; j < 8; ++j) { const f32x4 g = gn[64 * j]; o[64 * j] = (u32x2){cvtpk(v[j][0] * rstd * g[0], v[j][1] * rstd * g[1]), cvtpk(v[j][2] * rstd * g[2], v[j][3] * rstd * g[3])}; }
            }
            if (bid == 0) { CNT[tid] = 0u; CNT[512 + tid] = 0u; CNT[1024 + tid] = 0u; unsigned* bw = (unsigned*)(ws + WS_BAR); for (int i = tid; i < XCD_BAR_WORDS; i += 512) bw[i] = 0u; }
        } else if (EN_P1 && ph == 1 && bid < 8) {
            pg8::Gemm g{MEMB, WT_MKV, 512, 2048, DM}; pg8::MkvOrder S{bid}; pg8::EpiF32 E{MKV, 2048};
            pg8::gemm_phase<pg8::EpiF32, pg8::MkvOrder, true, true>(lds, g, S, E);
        } else if (EN_P0 && ph == 1) {
            TID_LOCALS
            LAS float* scr = (LAS float*)(lds + wave * 16640);
            const int gw = (bid - 8) * 8 + wave, NGW = (G - 8) * 8;
            constexpr int I_GU = 32 * 176, I_D = 88 * 32, I_IN = 32 * 80, I_OUT = 32 * 32, I_LAYER = 2 * I_GU + 2 * I_D + I_IN + I_OUT;
            for (int it = gw; it < 2 * I_LAYER; it += NGW) {
                const int l = it >= I_LAYER ? 1 : 0; int r = it - l * I_LAYER;
                bf16_t* wl = (bf16_t*)(ws + WS_WT + 8 * MiB + (size_t)l * WT_LAYER);
                if (r < I_GU) { tr_item((const float*)a.in[4] + (size_t)l * DM * 2 * DFF, DM, 2 * DFF, (bf16_t*)((unsigned char*)wl + WT_GU1), (const float*)a.in[3] + l * DM, 1, scr, r, lane); continue; } r -= I_GU;
                if (r < I_GU) { tr_item((const float*)a.in[17] + (size_t)l * DM * 2 * DFF, DM, 2 * DFF, (bf16_t*)((unsigned char*)wl + WT_GU2), (const float*)a.in[16] + l * DM, 1, scr, r, lane); continue; } r -= I_GU;
                if (r < I_D) { tr_item((const float*)a.in[5] + (size_t)l * DFF * DM, DFF, DM, (bf16_t*)((unsigned char*)wl + WT_D1), nullptr, 0, scr, r, lane); continue; } r -= I_D;
                if (r < I_D) { tr_item((const float*)a.in[18] + (size_t)l * DFF * DM, DFF, DM, (bf16_t*)((unsigned char*)wl + WT_D2), nullptr, 0, scr, r, lane); continue; } r -= I_D;
                if (r < I_IN) { tr_item((const float*)a.in[7] + (size_t)l * DM * INW, DM, INW, (bf16_t*)((unsigned char*)wl + WT_IN), (const float*)a.in[6] + l * DM, 0, scr, r, lane); continue; } r -= I_IN;
                tr_item((const float*)a.in[15] + (size_t)l * DM * DM, DM, DM, (bf16_t*)((unsigned char*)wl + WT_OUT), nullptr, 0, scr, r, lane);
            }
            for (int i = (bid - 8) * 512 + tid; i < SEQ * 64; i += (G - 8) * 512) {
                const int t = i >> 6, fi = i & 63; const float ang = (float)positions[t] * a.inv_freq[fi];
                double rev = (double)ang * 0.15915494309189535; rev -= __builtin_rint(rev); const float fr = (float)rev;
                ROPE[i] = (f32x2){__builtin_amdgcn_cosf(fr), __builtin_amdgcn_sinf(fr)};
            }
            for (int row = gw; row < SEQ; row += NGW) {
                const f32x4* xr = (const f32x4*)(x_in + (size_t)row * DM) + lane;
                f32x4 v[8]; float ss = 0.f;
#pragma unroll
                for (int j = 0; j < 8; ++j) { v[j] = xr[64 * j]; ss += (v[j][0] * v[j][0] + v[j][1] * v[j][1]) + (v[j][2] * v[j][2] + v[j][3] * v[j][3]); }
                ss = wave_sum(ss);
                u32x2* o = (u32x2*)(XB + (size_t)row * DM) + lane;
#pragma unroll
                for (int j = 0; j < 8; ++j) o[64 * j] = (u32x2){cvtpk(v[j][0], v[j][1]), cvtpk(v[j][2], v[j][3])};
                if (lane < 32) SSQ[(size_t)row * 32 + lane] = lane == 0 ? ss : 0.f;
            }
        } else {
            const int l = (ph - 2) / 10, s = (ph - 2) % 10;
            unsigned char* wl = ws + WS_WT + 8 * MiB + (size_t)l * WT_LAYER;
            if (EN_GU && (s == 0 || s == 8)) {
                pg8::Gemm g{XB, (const bf16_t*)(wl + (s == 0 ? WT_GU1 : WT_GU2)), SEQ, 2 * DFF, DM}; pg8::StaticOrder S; S.init(SEQ, 2 * DFF, G, bid);
                pg8::EpiSwiglu E{H, SSQ, {{0.f, 0.f, 0.f, 0.f}, {0.f, 0.f, 0.f, 0.f}}, -1};
                pg8::gemm_phase<pg8::EpiSwiglu, pg8::StaticOrder, true, true>(lds, g, S, E);
            } else if (EN_RES && (s == 1 || s == 7 || s == 9)) {
                const bool isout = (s == 7);
                pg8::Gemm g{isout ? MIX : H, (const bf16_t*)(wl + (s == 1 ? WT_D1 : (isout ? WT_OUT : WT_D2))), SEQ, DM, isout ? DM : DFF}; pg8::StaticOrder S; S.init(SEQ, DM, G, bid);
                pg8::EpiResid E{(ph == NPH - 1) ? X : nullptr, XB, SSQ, ((MK_DUP & 64) && rep == 0) ? 0.0f : (isout ? 1.0f : 0.5f)};
                pg8::gemm_phase<pg8::EpiResid, pg8::StaticOrder, true, true>(lds, g, S, E);
            } else if (EN_PROJ && s == 2) {
                pg8::Gemm g{XB, (const bf16_t*)(wl + WT_IN), SEQ, INW, DM}; pg8::StaticOrder S; S.init(SEQ, INW, G, bid);
                pg8::EpiProj E{PROJ, INW, SSQ, {{0.f, 0.f, 0.f, 0.f}, {0.f, 0.f, 0.f, 0.f}}, -1};
                pg8::gemm_phase<pg8::EpiProj, pg8::StaticOrder, true, true>(lds, g, S, E);
            } else if (EN_PRE && s == 3) {
                for (int it = bid; it < 1024; it += G) {
                    const int w = it & 255, kk = it >> 8, b = w & 63, sl = (w >> 6) + 4 * kk, tok0 = 256 * b;
                    if (sl < 8) {
                        TID_LOCALS
                        const int h = sl;
                        u32x4 qa[4], qc[4], ka[4], kc[4];
                        { const bf16_t* pq = PROJ + (size_t)(tok0 + (tid >> 1)) * INW + 128 * h + 32 * (tid & 1); const bf16_t* pk = pq + 1024;
#pragma unroll
                          for (int i = 0; i < 4; ++i) { qa[i] = *(const u32x4*)(pq + 8 * i); qc[i] = *(const u32x4*)(pq + 64 + 8 * i); ka[i] = *(const u32x4*)(pk + 8 * i); kc[i] = *(const u32x4*)(pk + 64 + 8 * i); } }
                        const int dch = tid & 15, tg = tid >> 4;
                        const bf16_t* vsrc = PROJ + (size_t)(tok0 + 8 * tg) * INW + 2048 + 128 * h + 8 * dch;
                        u32x4 rw[8];
#pragma unroll
                        for (int e = 0; e < 8; ++e) rw[e] = *(const u32x4*)(vsrc + (size_t)e * INW);
                        {
                        const bool dummy_ = (MK_DUP & 128) && rep == 0; bf16_t* ob_ = dummy_ ? MIX + (size_t)tok0 * DM + 128 * h : nullptr;
                        f32x4 rp[16]; { const f32x4* r4 = (const f32x4*)(ROPE + (size_t)(tok0 + (tid >> 1)) * 64 + 32 * (tid & 1));
#pragma unroll
                          for (int i = 0; i < 16; ++i) rp[i] = r4[i]; }
                        norm_rope_block(qa, qc, dummy_ ? ob_ : PROJ + (size_t)tok0 * INW + 128 * h, dummy_ ? DM : INW, (const float*)a.in[8] + l * HD, positions, rp, tok0, false, nullptr, lds, tid);
                        norm_rope_block(ka, kc, dummy_ ? ob_ : PROJ + (size_t)tok0 * INW + 1024 + 128 * h, dummy_ ? DM : INW, (const float*)a.in[9] + l * HD, positions, rp, tok0, true, KMEAN + (size_t)(h * 64 + b) * 128, lds, tid);
                        }
                        bf16_t* vdst = VT + ((size_t)(h * 64 + b) * 128 + 8 * dch) * 256 + 8 * tg;
#pragma unroll
                        for (int c = 0; c < 8; ++c) { u32x4 o;
#pragma unroll
                            for (int e2 = 0; e2 < 4; ++e2) { const unsigned lo = rw[2 * e2][c >> 1], hh = rw[2 * e2 + 1][c >> 1];
                                o[e2] = (c & 1) ? ((lo >> 16) | (hh & 0xffff0000u)) : ((lo & 0xffffu) | (hh << 16)); }
                            *(u32x4*)(vdst + (size_t)c * 256) = o; }
                    } else if (sl < 12) {
                        TID_LOCALS
                        const int g = sl - 8, ch = tid & 15, tl = tid >> 4, c0 = 128 * g + 8 * ch, t0 = tok0 + 8 * tl;
                        const float* cw = (const float*)a.in[10] + l * 3 * 512 + c0;
                        float w0[8], w1[8], w2[8];
#pragma unroll
                        for (int e = 0; e < 8; ++e) { w0[e] = cw[e]; w1[e] = cw[512 + e]; w2[e] = cw[1024 + e]; }
                        float um2[8], um1[8];
#pragma unroll
                        for (int e = 0; e < 8; ++e) { um2[e] = 0.f; um1[e] = 0.f; }
                        if (t0 >= 2) {
                            const u32x4 c2 = *(const u32x4*)(PROJ + (size_t)(t0 - 2) * INW + 3584 + c0), x2 = *(const u32x4*)(PROJ + (size_t)(t0 - 2) * INW + 4096 + c0);
                            const u32x4 c1 = *(const u32x4*)(PROJ + (size_t)(t0 - 1) * INW + 3584 + c0), x1 = *(const u32x4*)(PROJ + (size_t)(t0 - 1) * INW + 4096 + c0);
#pragma unroll
                            for (int e = 0; e < 4; ++e) { um2[2 * e] = bflo(c2[e]) * bflo(x2[e]); um2[2 * e + 1] = bfhi(c2[e]) * bfhi(x2[e]); um1[2 * e] = bflo(c1[e]) * bflo(x1[e]); um1[2 * e + 1] = bfhi(c1[e]) * bfhi(x1[e]); }
                        }
#pragma unroll
                        for (int k = 0; k < 8; ++k) { const size_t ro = (size_t)(t0 + k) * INW;
                            const u32x4 cb = *(const u32x4*)(PROJ + ro + 3072 + c0), cc = *(const u32x4*)(PROJ + ro + 3584 + c0), cx = *(const u32x4*)(PROJ + ro + 4096 + c0);
                            float uc[8], y[8];
#pragma unroll
                            for (int e = 0; e < 4; ++e) { uc[2 * e] = bflo(cc[e]) * bflo(cx[e]); uc[2 * e + 1] = bfhi(cc[e]) * bfhi(cx[e]); }
#pragma unroll
                            for (int e = 0; e < 8; ++e) y[e] = w0[e] * um2[e] + w1[e] * um1[e] + w2[e] * uc[e];
                            u32x4 o;
#pragma unroll
                            for (int e = 0; e < 4; ++e) o[e] = cvtpk(y[2 * e] * bflo(cb[e]), y[2 * e + 1] * bfhi(cb[e]));
                            *(u32x4*)(MIX + (size_t)(t0 + k) * DM + 1024 + c0) = o;
#pragma unroll
                            for (int e = 0; e < 8; ++e) { um2[e] = um1[e]; um1[e] = uc[e]; } }
                    } else {
                        TID_LOCALS
                        const int hm = sl - 12;
                        { const int m = tid >> 1, hf = tid & 1;
                          const f32x4* kr = (const f32x4*)(MKV + (size_t)(256 * l + m) * 2048 + 1024 * l + 128 * hm + 64 * hf);
                          const f32x4* gk = (const f32x4*)((const float*)a.in[14] + l * HD + 64 * hf);
                          f32x4 v[16]; float ss = 0.f;
#pragma unroll
                          for (int i = 0; i < 16; ++i) { v[i] = kr[i]; ss += (v[i][0] * v[i][0] + v[i][1] * v[i][1]) + (v[i][2] * v[i][2] + v[i][3] * v[i][3]); }
                          ss += __shfl_xor(ss, 1);
                          const float rstd = 1.0f / sqrtf(ss * (1.0f / 128.0f) + 1e-6f);
#pragma unroll
                          for (int i = 0; i < 8; ++i) { const f32x4 g0 = gk[2 * i], g1 = gk[2 * i + 1]; const f32x4 p0 = v[2 * i] * rstd * g0, p1 = v[2 * i + 1] * rstd * g1;
                              u32x4 o; o.x = cvtpk(p0[0], p0[1]); o.y = cvtpk(p0[2], p0[3]); o.z = cvtpk(p1[0], p1[1]); o.w = cvtpk(p1[2], p1[3]);
                              *(LAS u32x4*)(lds + LDS_KS + m * KS_STRIDE + 128 * hf + 16 * i) = o; }
                          const f32x4* vr = kr + 128;
#pragma unroll
                          for (int i = 0; i < 16; ++i) { const f32x4 vv = vr[i];
#pragma unroll
                              for (int e = 0; e < 4; ++e) *(LAS bf16_t*)(lds + LDS_VT + (64 * hf + 4 * i + e) * VT_STRIDE + 2 * m) = (bf16_t)(cvtpk(vv[e], 0.f) & 0xffffu); }
                        }
                        __syncthreads();
                        const int tok = tok0 + 32 * wave + r32;
                        const bf16_t* qrow = PROJ + (size_t)tok * INW + 4608 + 128 * hm + 8 * hi;
                        const float* gq = (const float*)a.in[13] + l * HD + 8 * hi;
                        u32x4 qr[8]; float ss = 0.f;
#pragma unroll
                        for (int d0 = 0; d0 < 8; ++d0) { qr[d0] = *(const u32x4*)(qrow + 16 * d0);
#pragma unroll
                            for (int e = 0; e < 4; ++e) { const float lo = bflo(qr[d0][e]), hh = bfhi(qr[d0][e]); ss += lo * lo + hh * hh; } }
                        ss += __shfl_xor(ss, 32);
                        const float rstd = 1.0f / sqrtf(ss * (1.0f / 128.0f) + 1e-6f);
                        bf16x8 qf[8];
#pragma unroll
                        for (int d0 = 0; d0 < 8; ++d0) { u32x4 o;
#pragma unroll
                            for (int e = 0; e < 4; ++e) o[e] = cvtpk(bflo(qr[d0][e]) * rstd * gq[16 * d0 + 2 * e], bfhi(qr[d0][e]) * rstd * gq[16 * d0 + 2 * e + 1]);
                            qf[d0] = __builtin_bit_cast(bf16x8, o); }
                        f32x16 O[4]; float m2, ll;
                        attn_tile<false>(lds + LDS_KS, lds + LDS_VT, qf, 0, r32, hi, O, m2, ll);
                        store_orow(MIX + (size_t)tok * DM + 1536 + 128 * hm, O, 1.0f / ll, hi, true);
                        __syncthreads();
                    }
                }
            } else if (EN_GATE && s == 4) {
                for (int it = bid; it < 512; it += G) {
                    TID_LOCALS
                    const int h = it & 7, qc = it >> 3;
                    if (qc == 0) continue;
                    { const int j = tid >> 3, dc = (tid & 7) * 16; const f32x4* src = (const f32x4*)(KMEAN + ((size_t)h * 64 + j) * 128 + dc);
                      u32x4 hw[2], lw[2];
#pragma unroll
                      for (int i = 0; i < 4; ++i) { const f32x4 v = src[i]; float r_[4];
#pragma unroll
                          for (int e = 0; e < 4; ++e) { const unsigned hb = cvtpk(v[e], 0.f) & 0xffffu; r_[e] = v[e] - __uint_as_float(hb << 16); }
                          hw[i >> 1][2 * (i & 1)] = cvtpk(v[0], v[1]); hw[i >> 1][2 * (i & 1) + 1] = cvtpk(v[2], v[3]);
                          lw[i >> 1][2 * (i & 1)] = cvtpk(r_[0], r_[1]); lw[i >> 1][2 * (i & 1) + 1] = cvtpk(r_[2], r_[3]); }
                      *(LAS u32x4*)(lds + j * KS_STRIDE + dc * 2) = hw[0]; *(LAS u32x4*)(lds + j * KS_STRIDE + dc * 2 + 16) = hw[1];
                      *(LAS u32x4*)(lds + 64 * KS_STRIDE + j * KS_STRIDE + dc * 2) = lw[0]; *(LAS u32x4*)(lds + 64 * KS_STRIDE + j * KS_STRIDE + dc * 2 + 16) = lw[1]; }
                    __syncthreads();
                    const int tok = 256 * qc + 32 * wave + r32;
                    const bf16_t* qrow = PROJ + (size_t)tok * INW + 128 * h + 8 * hi;
                    bf16x8 qf[8];
#pragma unroll
                    for (int d0 = 0; d0 < 8; ++d0) qf[d0] = *(const bf16x8*)(qrow + 16 * d0);
                    float b0 = -INFINITY, b1 = -INFINITY, b2 = -INFINITY; int i0 = 0, i1 = 0, i2 = 0;
#pragma unroll
                    for (int jt = 0; jt < 2; ++jt) {
                        if (jt == 0 || qc > 32) {
                            f32x16 g;
#pragma unroll
                            for (int r = 0; r < 16; ++r) g[r] = 0.f;
                            const LAS unsigned char* kp = lds + (32 * jt + r32) * KS_STRIDE + 16 * hi;
#pragma unroll
                            for (int d0 = 0; d0 < 8; ++d0) { const bf16x8 kh = *(const LAS bf16x8*)(kp + 32 * d0), kl = *(const LAS bf16x8*)(kp + 64 * KS_STRIDE + 32 * d0);
                                g = MFMA32(kh, qf[d0], g); g = MFMA32(kl, qf[d0], g); }
#pragma unroll
                            for (int r = 0; r < 16; ++r) { const int j = 32 * jt + crow(r, hi); const float v = g[r];
                                if (j < qc) {
                                    if (v > b0) { b2 = b1; i2 = i1; b1 = b0; i1 = i0; b0 = v; i0 = j; }
                                    else if (v > b1) { b2 = b1; i2 = i1; b1 = v; i1 = j; }
                                    else if (v > b2) { b2 = v; i2 = j; } } }
                        }
                    }
                    { const float o0 = __shfl_xor(b0, 32), o1 = __shfl_xor(b1, 32), o2 = __shfl_xor(b2, 32); const int p0 = __shfl_xor(i0, 32), p1 = __shfl_xor(i1, 32), p2 = __shfl_xor(i2, 32);
#define MK_INS(v, j) do { const float v_ = (v); const int j_ = (j); \
                          if (v_ > b0 || (v_ == b0 && j_ < i0)) { b2 = b1; i2 = i1; b1 = b0; i1 = i0; b0 = v_; i0 = j_; } \
                          else if (v_ > b1 || (v_ == b1 && j_ < i1)) { b2 = b1; i2 = i1; b1 = v_; i1 = j_; } \
                          else if (v_ > b2 || (v_ == b2 && j_ < i2)) { b2 = v_; i2 = j_; } } while (0)
                      MK_INS(o0, p0); MK_INS(o1, p1); MK_INS(o2, p2);
#undef MK_INS
                    }
                    LAS unsigned* cntl = (LAS unsigned*)(lds + LDS_MISC); LAS unsigned* basel = cntl + 64;
                    if (tid < 64) cntl[tid] = 0u;
                    __syncthreads();
                    unsigned r0 = 0u, r1 = 0u, r2 = 0u;
                    if (hi == 0) { r0 = atomicAdd((unsigned*)(cntl + i0), 1u); if (qc > 1) r1 = atomicAdd((unsigned*)(cntl + i1), 1u); if (qc > 2) r2 = atomicAdd((unsigned*)(cntl + i2), 1u); }
                    __syncthreads();
                    if (tid < 64) { const unsigned n = cntl[tid]; basel[tid] = n ? atomicAdd(CNT + l * 512 + h * 64 + tid, n) : 0u; }
                    __syncthreads();
                    if (hi == 0) {
                        LIST[(size_t)(h * 64 + i0) * SEQ + basel[i0] + r0] = ((unsigned)tok << 2) | 0u;
                        if (qc > 1) LIST[(size_t)(h * 64 + i1) * SEQ + basel[i1] + r1] = ((unsigned)tok << 2) | 1u;
                        if (qc > 2) LIST[(size_t)(h * 64 + i2) * SEQ + basel[i2] + r2] = ((unsigned)tok << 2) | 2u;
                    }
                    __syncthreads();
                }
            } else if (EN_SEL && s == 5) {
                LAS int* pre = (LAS int*)(lds + LDS_MISC); LAS int* wtot = (LAS int*)(lds + LDS_MISC + 2048);
                { TID_LOCALS
                  const int mycnt = (int)CNT[l * 512 + tid];
                  int v = (mycnt + 255) >> 8;
#pragma unroll
                  for (int o = 1; o < 64; o <<= 1) { const int t = __shfl_up(v, o); if (lane >= o) v += t; }
                  if (lane == 63) wtot[wave] = v;
                  __syncthreads();
                  int add = 0;
#pragma unroll
                  for (int w = 0; w < 8; ++w) add += (w < wave) ? wtot[w] : 0;
                  pre[tid] = v + add;
                  __syncthreads(); }
                const int total = pre[511];
                const int vcu = (G % 8 == 0) ? (bid % 8) * (G / 8) + bid / 8 : bid;
                for (int it = vcu; it < total; it += G) {
                    TID_LOCALS
                    int lo = 0, hh = 511;
                    while (lo < hh) { const int mid = (lo + hh) >> 1; if (pre[mid] > it) hh = mid; else lo = mid + 1; }
                    const int p = lo, chunk = it - (p ? pre[p - 1] : 0), h = p >> 6, b = p & 63;
                    const int pc = (int)CNT[l * 512 + p];
                    stage_kv(lds, PROJ + (size_t)(256 * b) * INW + 1024 + 128 * h, INW, VT + (size_t)(h * 64 + b) * 128 * 256, tid);
                    __syncthreads();
                    const int e = chunk * 256 + 32 * wave + r32; const bool valid = e < pc;
                    const unsigned ent = LIST[(size_t)p * SEQ + (valid ? e : 0)]; const int tok = (int)(ent >> 2), slot = (int)(ent & 3u);
                    const bf16_t* qrow = PROJ + (size_t)tok * INW + 128 * h + 8 * hi;
                    bf16x8 qf[8];
#pragma unroll
                    for (int d0 = 0; d0 < 8; ++d0) qf[d0] = *(const bf16x8*)(qrow + 16 * d0);
                    f32x16 O[4]; float m2, ll;
                    attn_tile<false>(lds + LDS_KS, lds + LDS_VT, qf, 0, r32, hi, O, m2, ll);
                    { const size_t pi = ((size_t)h * SEQ + tok) * 3 + slot;
                      store_orow(PART + pi * 128, O, 1.0f / ll, hi, valid);
                      if (valid && hi == 0) ML[pi] = (f32x2){m2, ll}; }
                    __syncthreads();
                }
            } else if (EN_OWN && s == 6) {
                for (int it = bid; it < 512; it += G) {
                    TID_LOCALS
                    const int h = it & 7, b = it >> 3;
                    stage_kv(lds, PROJ + (size_t)(256 * b) * INW + 1024 + 128 * h, INW, VT + (size_t)(h * 64 + b) * 128 * 256, tid);
                    __syncthreads();
                    const int qi = 32 * wave + r32, tok = 256 * b + qi;
                    const bf16_t* qrow = PROJ + (size_t)tok * INW + 128 * h + 8 * hi;
                    bf16x8 qf[8];
#pragma unroll
                    for (int d0 = 0; d0 < 8; ++d0) qf[d0] = *(const bf16x8*)(qrow + 16 * d0);
                    f32x16 O[4]; float m2, ll;
                    attn_tile<true>(lds + LDS_KS, lds + LDS_VT, qf, qi, r32, hi, O, m2, ll);
                    const int nsel = b < 3 ? b : 3; const size_t pi = ((size_t)h * SEQ + tok) * 3;
                    float M = m2;
#pragma unroll 1
                    for (int t = 0; t < nsel; ++t) M = fmaxf(M, ML[pi + t].x);
                    const float wo = __builtin_amdgcn_exp2f(m2 - M); float den = ll * wo;
#pragma unroll
                    for (int d = 0; d < 4; ++d)
#pragma unroll
                        for (int r = 0; r < 16; ++r) O[d][r] *= wo;
#pragma unroll 1
                    for (int t = 0; t < nsel; ++t) { const f32x2 ml = ML[pi + t]; const float wt = ml.y * __builtin_amdgcn_exp2f(ml.x - M); den += wt; addmul_prow(O, PART + (pi + t) * 128, wt, hi); }
                    store_orow(MIX + (size_t)tok * DM + 128 * h, O, 1.0f / den, hi, true);
                    __syncthreads();
                }
            }
        }
        }
#if MK_COOP
        if (ph + 1 < a.ph_hi) {
            if (ph == a.ph_lo) { grid.sync(); bar = xcd_barrier_post((unsigned*)(a.ws + WS_BAR), bst); }
            else xcd_barrier(bar);
        }
#endif
        if ((MK_DUP & 256) && s_ == 3 && redo_ == 0) { redo_ = 1; ph -= 2; } else if (s_ == 4) redo_ = 0;
    }
}

extern "C" void kernel_launch(void* const* d_in, const int* in_sizes, int n_in, void* d_out, int out_size, void* d_ws, size_t ws_size, hipStream_t stream) {
    static int grid = 0;
    if (grid == 0) {
        if (n_in != 19 || out_size != SEQ * DM || ws_size < WS_END) { fprintf(stderr, "kernel_launch: unexpected shapes (n_in %d, out %d, ws %zu); nothing launched\n", n_in, out_size, ws_size); grid = -1; return; }
        int dev = 0, cus = 0, per_cu = 0;
        if (hipGetDevice(&dev) != hipSuccess || hipDeviceGetAttribute(&cus, hipDeviceAttributeMultiprocessorCount, dev) != hipSuccess) { grid = -1; return; }
        if (hipFuncSetAttribute((const void*)mk_fwd, hipFuncAttributeMaxDynamicSharedMemorySize, LDS_BYTES) != hipSuccess) { fprintf(stderr, "kernel_launch: hipFuncSetAttribute failed\n"); grid = -1; return; }
        if (hipOccupancyMaxActiveBlocksPerMultiprocessor(&per_cu, (const void*)mk_fwd, 512, LDS_BYTES) != hipSuccess || per_cu < 1) { fprintf(stderr, "kernel_launch: occupancy query gave %d\n", per_cu); per_cu = 1; }
        (void)hipGetLastError();
        grid = cus * per_cu;
        fprintf(stderr, "kernel_launch: grid %d (%d CUs x %d)\n", grid, cus, per_cu);
    }
    if (grid < 0) return;
    Args a{};
    for (int i = 0; i < 19; ++i) a.in[i] = d_in[i];
    a.out = (float*)d_out; a.ws = (unsigned char*)d_ws;
    for (int i = 0; i < 64; ++i) a.inv_freq[i] = (float)pow(10000.0, -(double)(2 * i) / 128.0);
#if MK_COOP
    a.ph_lo = 0; a.ph_hi = NPH;
    void* args[] = {&a};
    const hipError_t e = hipLaunchCooperativeKernel((const void*)mk_fwd, dim3(grid), dim3(512), args, LDS_BYTES, stream);
    if (e != hipSuccess) fprintf(stderr, "kernel_launch: cooperative launch failed: %s (grid %d)\n", hipGetErrorString(e), grid);
#else
    for (int ph = 0; ph < NPH; ++ph) { a.ph_lo = ph; a.ph_hi = ph + 1; hipLaunchKernelGGL(mk_fwd, dim3(grid), dim3(512), LDS_BYTES, stream, a); }
#endif
}
```
